# Optimizing an MI355X kernel written in HIP

```python
import jax, jax.numpy as jnp
from jax import lax
import numpy as np

D_MODEL = 1024
BATCH = 2
SEQ = 16384
DEPTH = 4
DEC_BATCH = 8
DEC_SEQ = 4096
PAST_LEN = 128

N_EVEN = (DEPTH + 1) // 2
N_ODD = DEPTH // 2
D_FF = 2816
CHUNK = 64
LN_EPS = 1e-5
ALPHA = (2 * DEPTH) ** 0.25
BETA = (8 * DEPTH) ** -0.25
NEG_BIG = -1e30
TINY = 1e-30

A_HEADS = 4
A_DH = 128
A_W = A_HEADS * A_DH
CONV_W = 5
B_HEADS = 4
B_DK = 64
B_DV = 128
B_KW = B_HEADS * B_DK
B_VW = B_HEADS * B_DV
B_RANK = 16
GLA_GATE_NORMALIZER = 16.0
C_HEADS = 4
C_DK = 128
C_DV = 128
C_KW = C_HEADS * C_DK
C_VW = C_HEADS * C_DV
R_HEADS = 4
R_DK = 128
R_DV = 128
R_KW = R_HEADS * R_DK
R_VW = R_HEADS * R_DV
ROPE_BASE = 10000.0

EV_SIZES = (A_W, A_W, A_W, A_W, 4 * A_HEADS, B_KW, B_KW, B_VW, B_VW, 2 * B_RANK)
EV_COLS = 4 * A_W + 4 * A_HEADS + 2 * B_KW + 2 * B_VW + 2 * B_RANK
EV_MIX = A_W + B_VW
OD_SIZES = (C_KW, C_KW, C_KW, C_VW, C_VW, R_KW, R_KW, R_VW, R_VW)
OD_COLS = 3 * C_KW + 2 * C_VW + 2 * R_KW + 2 * R_VW
OD_MIX = C_VW + R_VW

kernel_name = "hybrid_bidir_mlstm_gla_hgrn2_retnet_encoder"


def _split(y, sizes):
    out, off = [], 0
    for s in sizes:
        out.append(y[..., off:off + s])
        off += s
    return out


def _heads(t, n_heads):
    b, n, c = t.shape
    return t.reshape(b, n, n_heads, c // n_heads).transpose(0, 2, 1, 3)


def _merge_heads(t):
    b, h, n, d = t.shape
    return t.transpose(0, 2, 1, 3).reshape(b, n, h * d)


def _dir_stack(fwd, bwd):
    return jnp.concatenate([fwd, jnp.flip(bwd, axis=2)], axis=0)


def _dir_merge(y):
    b = y.shape[0] // 2
    return y[:b] + jnp.flip(y[b:], axis=2)


def _to_chunks(t):
    b, h, n, d = t.shape
    return jnp.moveaxis(t.reshape(b, h, n // CHUNK, CHUNK, d), 2, 0)


def _from_chunks(t):
    nc, b, h, l, d = t.shape
    return jnp.moveaxis(t, 0, 2).reshape(b, h, nc * l, d)


def _layer_norm(x, g, b):
    xf = x.astype(jnp.float32)
    mu = jnp.mean(xf, -1, keepdims=True)
    var = jnp.mean(jnp.square(xf - mu), -1, keepdims=True)
    return ((xf - mu) * lax.rsqrt(var + LN_EPS) * g.astype(jnp.float32) + b.astype(jnp.float32)).astype(x.dtype)


def _head_layernorm(x):
    xf = x.astype(jnp.float32)
    mu = jnp.mean(xf, -1, keepdims=True)
    var = jnp.mean(jnp.square(xf - mu), -1, keepdims=True)
    return ((xf - mu) * lax.rsqrt(var + LN_EPS)).astype(x.dtype)


def _head_rmsnorm(x):
    xf = x.astype(jnp.float32)
    return (xf * lax.rsqrt(jnp.mean(jnp.square(xf), -1, keepdims=True) + LN_EPS)).astype(x.dtype)


def _swiglu(x, w_in, w_out):
    g, u = jnp.split(x @ w_in, 2, axis=-1)
    return (jax.nn.silu(g) * u) @ w_out


def _centred_dwconv(x, w):
    pad = CONV_W // 2
    n = x.shape[1]
    xp = jnp.pad(x, ((0, 0), (pad, pad), (0, 0)))
    acc = xp[:, 0:n, :] * w[0]
    for j in range(1, CONV_W):
        acc = acc + xp[:, j:j + n, :] * w[j]
    return acc


def _rotary(x):
    n, d = x.shape[2], x.shape[3]
    inv = 1.0 / (ROPE_BASE ** (jnp.arange(0, d, 2, dtype=jnp.float32) / d))
    ang = jnp.arange(n, dtype=jnp.float32)[:, None] * inv[None, :]
    cos, sin = jnp.cos(ang), jnp.sin(ang)
    xf = x.astype(jnp.float32)
    x1, x2 = xf[..., : d // 2], xf[..., d // 2:]
    return jnp.concatenate([x1 * cos - x2 * sin, x1 * sin + x2 * cos], -1).astype(x.dtype)


def _causal_mask():
    return jnp.tril(jnp.ones((CHUNK, CHUNK), dtype=bool))


def gated_linear_chunked(q, k, v, log_f):
    b, h, n, dk = q.shape
    dv = v.shape[-1]
    xs = tuple(_to_chunks(t.astype(jnp.float32)) for t in (q, k, v, log_f))
    mask = _causal_mask()
    vector_decay = log_f.shape[-1] > 1

    def step(state, inp):
        qc, kc, vc, gc = inp
        bcum = jnp.cumsum(gc, axis=-2)
        b_end = bcum[..., -1:, :]
        o = jnp.einsum('bhtd,bhde->bhte', qc * jnp.exp(bcum), state)
        if vector_decay:
            rel = jnp.where(mask[:, :, None], bcum[..., :, None, :] - bcum[..., None, :, :], NEG_BIG)
            scores = jnp.einsum('bhtd,bhsd,bhtsd->bhts', qc, kc, jnp.exp(rel))
        else:
            rel = jnp.where(mask, bcum[..., :, None, 0] - bcum[..., None, :, 0], NEG_BIG)
            scores = jnp.einsum('bhtd,bhsd->bhts', qc, kc) * jnp.exp(rel)
        o = o + jnp.einsum('bhts,bhse->bhte', scores, vc)
        state = jnp.exp(jnp.swapaxes(b_end, -1, -2)) * state + jnp.einsum('bhsd,bhse->bhde', kc * jnp.exp(b_end - bcum), vc)
        return state, o

    s0 = jnp.zeros((b, h, dk, dv), jnp.float32)
    _, o = lax.scan(step, s0, xs)
    return _from_chunks(o).astype(v.dtype)


def mlstm_chunked(q, k, v, log_i, log_f):
    b, h, n, dk = q.shape
    dv = v.shape[-1]
    xs = tuple(_to_chunks(t.astype(jnp.float32)) for t in (q, k, v, log_i, log_f))
    mask = _causal_mask()

    def step(carry, inp):
        c_mat, n_vec, m = carry
        qc, kc, vc, ic, fc = inp
        ic, fc = ic[..., 0], fc[..., 0]
        bcum = jnp.cumsum(fc, axis=-1)
        dmat = jnp.where(mask, bcum[..., :, None] - bcum[..., None, :] + ic[..., None, :], NEG_BIG)
        m_inter = bcum + m[..., None]
        m_t = jnp.maximum(m_inter, jnp.max(dmat, axis=-1))
        att = jnp.einsum('bhtd,bhsd->bhts', qc, kc) * jnp.exp(dmat - m_t[..., None])
        sc = jnp.exp(m_inter - m_t)
        num = sc[..., None] * jnp.einsum('bhtd,bhde->bhte', qc, c_mat) + jnp.einsum('bhts,bhse->bhte', att, vc)
        den = sc * jnp.einsum('bhtd,bhd->bht', qc, n_vec) + jnp.sum(att, -1)
        out = num / jnp.maximum(jnp.abs(den), jnp.exp(-m_t))[..., None]
        g_end = bcum[..., -1:] - bcum + ic
        m_new = jnp.maximum(bcum[..., -1] + m, jnp.max(g_end, -1))
        decay = jnp.exp(bcum[..., -1] + m - m_new)
        wk = kc * jnp.exp(g_end - m_new[..., None])[..., None]
        c_mat = decay[..., None, None] * c_mat + jnp.einsum('bhsd,bhse->bhde', wk, vc)
        n_vec = decay[..., None] * n_vec + jnp.sum(wk, -2)
        return (c_mat, n_vec, m_new), out

    init = (jnp.zeros((b, h, dk, dv), jnp.float32), jnp.zeros((b, h, dk), jnp.float32), jnp.zeros((b, h), jnp.float32))
    _, o = lax.scan(step, init, xs)
    return _from_chunks(o).astype(v.dtype)


def _even_mixer(x, w_in, gate_b, conv_w, a2_w, a2_b, norm_w, w_out):
    bz = x.shape[0]
    y = x @ w_in
    aq, ak, av, ao, ag, bq, bk, bv, bg, ba = _split(y, EV_SIZES)
    qk = jax.nn.silu(_centred_dwconv(jnp.concatenate([aq, ak], -1), conv_w))
    q = _heads(qk[..., :A_W], A_HEADS)
    k = _heads(qk[..., A_W:], A_HEADS) * A_DH ** -0.5
    v = _heads(av, A_HEADS)
    gates = (ag + gate_b).astype(jnp.float32)
    gates = gates.reshape(bz, -1, 4, A_HEADS).transpose(2, 0, 3, 1)[..., None]
    log_i = _dir_stack(gates[0], gates[2])
    log_f = jax.nn.log_sigmoid(_dir_stack(gates[1], gates[3]))
    h_a = _dir_merge(mlstm_chunked(_dir_stack(q, q), _dir_stack(k, k), _dir_stack(v, v), log_i, log_f))
    h_a = _merge_heads(_head_layernorm(h_a)) * norm_w[:A_W] * jax.nn.sigmoid(ao)
    q = _heads(bq, B_HEADS) * B_DK ** -0.5
    k = _heads(bk, B_HEADS)
    v = _heads(bv, B_HEADS)
    a_pre = jnp.einsum('bnjr,jrc->jbnc', ba.reshape(bz, -1, 2, B_RANK), a2_w) + a2_b[:, None, None, :]
    log_a = jax.nn.log_sigmoid(a_pre.astype(jnp.float32)) / GLA_GATE_NORMALIZER
    log_a = _dir_stack(_heads(log_a[0], B_HEADS), _heads(log_a[1], B_HEADS))
    h_b = _dir_merge(gated_linear_chunked(_dir_stack(q, q), _dir_stack(k, k), _dir_stack(v, v), log_a))
    h_b = _merge_heads(_head_rmsnorm(h_b)) * norm_w[A_W:] * jax.nn.silu(bg)
    return jnp.concatenate([h_a, h_b], -1) @ w_out


def _odd_mixer(x, w_in, lb_logits, layer_idx, norm_w, w_out):
    bz = x.shape[0]
    y = x @ w_in
    cq, cf_fwd, cf_bwd, ci, cg, rq, rk, rv, rg = _split(y, OD_SIZES)
    p = jax.nn.softmax(lb_logits.astype(jnp.float32), axis=0)
    lb = (jnp.cumsum(p, axis=0) - p[0])[layer_idx]

    def forget(z, lb_dir):
        z = z.astype(jnp.float32)
        f = lb_dir + (1.0 - lb_dir) * jax.nn.sigmoid(z)
        log_f = jnp.log(jnp.maximum(f, TINY))
        key = (1.0 - lb_dir) * jax.nn.sigmoid(-z)
        return _heads(log_f, C_HEADS), _heads(key, C_HEADS)

    lf_f, k_f = forget(cf_fwd, lb[0])
    lf_b, k_b = forget(cf_bwd, lb[1])
    q = _heads(jax.nn.silu(cq), C_HEADS) * C_DK ** -0.5
    v = _heads(ci, C_HEADS)
    h_c = _dir_merge(gated_linear_chunked(_dir_stack(q, q), _dir_stack(k_f, k_b), _dir_stack(v, v), _dir_stack(lf_f, lf_b)))
    h_c = _merge_heads(_head_rmsnorm(h_c)) * norm_w * jax.nn.silu(cg)
    q = _rotary(_heads(rq, R_HEADS))
    k = _rotary(_heads(rk, R_HEADS)) * R_DK ** -0.5
    v = _heads(rv, R_HEADS)
    n = x.shape[1]
    log_gamma = jnp.log1p(-(2.0 ** (-5.0 - jnp.arange(R_HEADS, dtype=jnp.float32))))
    lg = jnp.broadcast_to(log_gamma[None, :, None, None], (2 * bz, R_HEADS, n, 1))
    h_d = _dir_merge(gated_linear_chunked(_dir_stack(q, q), _dir_stack(k, k), _dir_stack(v, v), lg))
    h_d = _merge_heads(_head_layernorm(h_d)) * jax.nn.silu(rg)
    return jnp.concatenate([h_c, h_d], -1) @ w_out


def _trunk(x, ffn1_w_in, ffn1_w_out, ffn2_w_in, ffn2_w_out, ln_g, ln_b,
           ev_w_in, ev_gate_b, ev_conv_w, ev_gla_a2_w, ev_gla_a2_b, ev_norm_w, ev_w_out,
           od_w_in, od_lb_logits, od_norm_w, od_w_out):
    for l in range(DEPTH):
        j = l // 2
        x = _layer_norm(ALPHA * x + 0.5 * _swiglu(x, ffn1_w_in[l], ffn1_w_out[l]), ln_g[l, 0], ln_b[l, 0])
        if l % 2 == 0:
            mix = _even_mixer(x, ev_w_in[j], ev_gate_b[j], ev_conv_w[j], ev_gla_a2_w[j], ev_gla_a2_b[j], ev_norm_w[j], ev_w_out[j])
        else:
            mix = _odd_mixer(x, od_w_in[j], od_lb_logits, j, od_norm_w[j], od_w_out[j])
        x = _layer_norm(ALPHA * x + mix, ln_g[l, 1], ln_b[l, 1])
        x = _layer_norm(ALPHA * x + 0.5 * _swiglu(x, ffn2_w_in[l], ffn2_w_out[l]), ln_g[l, 2], ln_b[l, 2])
    return x


def setup_inputs(seed: int = 0) -> dict:
    key = jax.random.key(seed)
    ks = jax.random.split(key, 20)

    def nrm(k, shape, scale):
        return jax.random.normal(k, shape, jnp.float32) * scale

    f_bias = jnp.linspace(3.0, 6.0, A_HEADS, dtype=jnp.float32)
    i_bias = jnp.zeros((A_HEADS,), jnp.float32)
    gate_base = jnp.concatenate([i_bias, f_bias, i_bias, f_bias])
    return {
        "x_prompt": nrm(ks[0], (BATCH, SEQ, D_MODEL), 1.0),
        "x_sample": nrm(ks[1], (DEC_BATCH, DEC_SEQ, D_MODEL), 1.0),
        "ffn1_w_in": nrm(ks[2], (DEPTH, D_MODEL, 2 * D_FF), D_MODEL ** -0.5),
        "ffn1_w_out": nrm(ks[3], (DEPTH, D_FF, D_MODEL), BETA * D_FF ** -0.5),
        "ffn2_w_in": nrm(ks[4], (DEPTH, D_MODEL, 2 * D_FF), D_MODEL ** -0.5),
        "ffn2_w_out": nrm(ks[5], (DEPTH, D_FF, D_MODEL), BETA * D_FF ** -0.5),
        "ln_g": 1.0 + nrm(ks[6], (DEPTH, 3, D_MODEL), 0.02),
        "ln_b": nrm(ks[7], (DEPTH, 3, D_MODEL), 0.02),
        "ev_w_in": nrm(ks[8], (N_EVEN, D_MODEL, EV_COLS), D_MODEL ** -0.5),
        "ev_gate_b": gate_base[None, :] + nrm(ks[9], (N_EVEN, 4 * A_HEADS), 0.1),
        "ev_conv_w": nrm(ks[10], (N_EVEN, CONV_W, 2 * A_W), CONV_W ** -0.5),
        "ev_gla_a2_w": nrm(ks[11], (N_EVEN, 2, B_RANK, B_KW), B_RANK ** -0.5),
        "ev_gla_a2_b": nrm(ks[12], (N_EVEN, 2, B_KW), 0.02),
        "ev_norm_w": 1.0 + nrm(ks[13], (N_EVEN, EV_MIX), 0.02),
        "ev_w_out": nrm(ks[14], (N_EVEN, EV_MIX, D_MODEL), BETA * EV_MIX ** -0.5),
        "od_w_in": nrm(ks[15], (N_ODD, D_MODEL, OD_COLS), D_MODEL ** -0.5),
        "od_lb_logits": nrm(ks[16], (N_ODD, 2, C_KW), 0.5),
        "od_norm_w": 1.0 + nrm(ks[17], (N_ODD, C_VW), 0.02),
        "od_w_out": nrm(ks[18], (N_ODD, OD_MIX, D_MODEL), BETA * OD_MIX ** -0.5),
    }


def reference(x_prompt, x_sample, ffn1_w_in, ffn1_w_out, ffn2_w_in, ffn2_w_out, ln_g, ln_b,
              ev_w_in, ev_gate_b, ev_conv_w, ev_gla_a2_w, ev_gla_a2_b, ev_norm_w, ev_w_out,
              od_w_in, od_lb_logits, od_norm_w, od_w_out):
    y_prompt = _trunk(x_prompt, ffn1_w_in, ffn1_w_out, ffn2_w_in, ffn2_w_out, ln_g, ln_b,
                      ev_w_in, ev_gate_b, ev_conv_w, ev_gla_a2_w, ev_gla_a2_b, ev_norm_w, ev_w_out,
                      od_w_in, od_lb_logits, od_norm_w, od_w_out)
    y_sample = _trunk(x_sample, ffn1_w_in, ffn1_w_out, ffn2_w_in, ffn2_w_out, ln_g, ln_b,
                      ev_w_in, ev_gate_b, ev_conv_w, ev_gla_a2_w, ev_gla_a2_b, ev_norm_w, ev_w_out,
                      od_w_in, od_lb_logits, od_norm_w, od_w_out)
    return (y_prompt, y_sample)
```

```cpp
#include <hip/hip_runtime.h>
#include <hip/hip_cooperative_groups.h>
namespace pg8 {
#define PG8_LAS __attribute__((address_space(3)))
typedef unsigned short bf16_t;
typedef short bf16x8 __attribute__((ext_vector_type(8)));
typedef float f32x4 __attribute__((ext_vector_type(4)));
typedef unsigned u32x4 __attribute__((ext_vector_type(4)));
constexpr int BM = 256, BK = 64, HALF = 128, HTB = HALF * BK * 2  , STAGE_BYTES = 8 * HTB, NXCD = 8, WGM = 8;

__host__ __device__ __forceinline__ int lds_byte(int r, int c) { const int st = (r >> 4) * 2 + (c >> 5), rr = r & 15, cc = c & 31, ob = rr * 64 + cc * 2; return st * 1024 + (ob ^ (((ob >> 9) & 1) << 5)); }
__host__ __device__ __forceinline__ void stage_rc(int b, int& R, int& C) { const int st = b / 1024, sb = b % 1024, swz = sb ^ (((sb >> 9) & 1) << 5); R = (st >> 1) * 16 + swz / 64; C = (st & 1) * 32 + (swz % 64) / 2; }
__host__ __device__ __forceinline__ int perm32(int rho) { const int n = rho >> 4, i = rho & 15; return 8 * (i >> 2) + 4 * n + (i & 3); }

struct Unit { int pm, pn; };
struct Gemm { const bf16_t* A; const bf16_t* Bt; int M, N, K; };

struct StaticOrder {
    int nM, nN, nwg, G, c;
    __host__ __device__ void init(int M, int N, int G_, int c_) { nM = M / BM; nN = N / BM; nwg = nM * nN; G = G_; c = c_; }
    __host__ __device__ bool next(int i, Unit& u) const {
        const long L = (long)i * G + c; if (L >= nwg) return false;
        int wgid = (int)L; { const int q = nwg / NXCD, r = nwg % NXCD, xcd = wgid % NXCD, off = wgid / NXCD; wgid = (xcd < r ? xcd * (q + 1) : r * (q + 1) + (xcd - r) * q) + off; }
        const int nig = WGM * nN, gid = wgid / nig, fm = gid * WGM, gsz = (nM - fm) < WGM ? (nM - fm) : WGM;
        u.pm = fm + ((wgid % nig) % gsz); u.pn = (wgid % nig) / gsz; return true;
    }
    __device__ __forceinline__ void a_ready(const Unit&) const {}
    __device__ __forceinline__ void done(const Unit&) const {}
};
__device__ __forceinline__ unsigned cvt_pk_bf16(float lo, float hi) { unsigned r; asm volatile("v_cvt_pk_bf16_f32 %0, %1, %2" : "=v"(r) : "v"(lo), "v"(hi)); return r; }

template <class Epi, class Sched, bool STAMP = false>
__device__ __forceinline__ void gemm_phase(PG8_LAS unsigned char* lds, const Gemm g, const Sched& S, const Epi& E, unsigned long long* stamps) {
    int tid_o = threadIdx.x; asm volatile("" : "+v"(tid_o)); const int tid = tid_o, wid = __builtin_amdgcn_readfirstlane(tid >> 6), lane = tid & 63, wr = wid >> 2, wc = wid & 3, fr = lane & 15, fq = lane >> 4;
    const int K = g.K, nt = K / BK;
    int ts_lo = 0, ts_hi = 0, nts = 0; const unsigned long long rt_entry = STAMP ? (unsigned long long)wall_clock64() : 0ull;
#define PG8_STAMP() do { if (STAMP && wid == 0 && nts < 64) { const unsigned long long _c = (unsigned long long)clock64(); \
        ts_lo = (lane == nts) ? (int)(unsigned)_c : ts_lo; ts_hi = (lane == nts) ? (int)(unsigned)(_c >> 32) : ts_hi; ++nts; } } while (0)
    PG8_STAMP();
    unsigned voffA[2], voffB[2];
#pragma unroll
    for (int i = 0; i < 2; ++i) { int R, C; stage_rc(tid * 16 + i * 8192, R, C); const int Rb = Epi::PERM ? ((R & ~31) + perm32(R & 31)) : R;
        voffA[i] = (unsigned)(R * K + C) * 2u; voffB[i] = (unsigned)(Rb * K + C) * 2u; }
    const size_t kstep = (size_t)(BK * 2);
    const size_t hstep = (size_t)HALF * K * 2;
    const size_t tstep = 2 * hstep;
    const unsigned ldsw = (unsigned)wid * 1024u;
    const int aoff = lds_byte(wr * 64 + fr, fq * 8), boff = lds_byte(wc * 32 + fr, fq * 8);
#define PG8_SA(b, h) (((b) * 2 + (h)) * HTB)
#define PG8_SB(b, h) ((4 + (b) * 2 + (h)) * HTB)
#define PG8_STAGE(bufoff, gbase, voff) do { _Pragma("unroll") for (int _i = 0; _i < 2; ++_i) \
        __builtin_amdgcn_global_load_lds((const unsigned*)((const char*)(gbase) + (voff)[_i]), (PG8_LAS unsigned*)(lds + (bufoff) + ldsw + _i * 8192), 16, 0, 0); } while (0)
#define PG8_LDA(dst, b, h) do { _Pragma("unroll") for (int m = 0; m < 4; ++m) _Pragma("unroll") for (int k = 0; k < 2; ++k) dst[m][k] = *(const PG8_LAS bf16x8*)(lds + PG8_SA(b, h) + aoff + m * 2048 + k * 1024); } while (0)
#define PG8_LDB(dst, b, h) do { _Pragma("unroll") for (int n = 0; n < 2; ++n) _Pragma("unroll") for (int k = 0; k < 2; ++k) dst[n][k] = *(const PG8_LAS bf16x8*)(lds + PG8_SB(b, h) + boff + n * 2048 + k * 1024); } while (0)
#define PG8_MMA(ai, bj, At, Bt) do { __builtin_amdgcn_s_setprio(1); _Pragma("unroll") for (int m = 0; m < 4; ++m) _Pragma("unroll") for (int n = 0; n < 2; ++n) _Pragma("unroll") for (int k = 0; k < 2; ++k) \
        acc[ai][bj][m][n] = __builtin_amdgcn_mfma_f32_16x16x32_bf16(Bt[n][k], At[m][k], acc[ai][bj][m][n], 0, 0, 0); __builtin_amdgcn_s_setprio(0); } while (0)
#define PG8_WAIT_V(n) asm volatile("s_waitcnt vmcnt(" #n ")" ::: "memory")
#define PG8_WAIT_L(n) asm volatile("s_waitcnt lgkmcnt(" #n ")" ::: "memory")
#define PG8_BAR __builtin_amdgcn_s_barrier()
#define PG8_SCHED __builtin_amdgcn_sched_barrier(0)
    Unit cur, nxt; int ui = 0;
    if (!S.next(0, cur)) return;
    f32x4 acc[2][2][4][2];
#pragma unroll
    for (int a = 0; a < 2; ++a)
#pragma unroll
        for (int b = 0; b < 2; ++b)
#pragma unroll
            for (int m = 0; m < 4; ++m)
#pragma unroll
                for (int n = 0; n < 2; ++n) acc[a][b][m][n] = (f32x4){0.f, 0.f, 0.f, 0.f};
    bf16x8 At[4][2], B0[2][2], B1[2][2];
    const char* cA = (const char*)g.A + (size_t)cur.pm * tstep; const char* cB = (const char*)g.Bt + (size_t)cur.pn * tstep;
    S.a_ready(cur);
    PG8_STAGE(PG8_SB(0, 0), cB, voffB); PG8_STAGE(PG8_SA(0, 0), cA, voffA); PG8_STAGE(PG8_SB(0, 1), cB + hstep, voffB); PG8_STAGE(PG8_SA(0, 1), cA + hstep, voffA);
    if (wr == 1) PG8_BAR;
    PG8_WAIT_V(4); PG8_BAR;
    PG8_STAGE(PG8_SB(1, 0), cB + kstep, voffB); PG8_STAGE(PG8_SA(1, 0), cA + kstep, voffA); PG8_STAGE(PG8_SB(1, 1), cB + hstep + kstep, voffB);
    PG8_WAIT_V(6); PG8_BAR;
    PG8_STAMP();
    for (;;) {
        const bool has_next = S.next(ui + 1, nxt);
        const char* nA = has_next ? (const char*)g.A + (size_t)nxt.pm * tstep : cA; const char* nB = has_next ? (const char*)g.Bt + (size_t)nxt.pn * tstep : cB;
        for (int t = 0; t < nt; t += 2) {
            const bool last = (t == nt - 2);
            const char* a1 = cA + (size_t)(t + 1) * kstep;
            const char* a2 = last ? nA : cA + (size_t)(t + 2) * kstep; const char* b2 = last ? nB : cB + (size_t)(t + 2) * kstep;
            const char* a3 = a2 + kstep; const char* b3 = b2 + kstep;
            if (last && has_next) S.a_ready(nxt);
            PG8_LDB(B0, 0, 0); PG8_SCHED; PG8_LDA(At, 0, 0); PG8_STAGE(PG8_SA(1, 1), a1 + hstep, voffA);
            PG8_WAIT_L(8); PG8_BAR; PG8_WAIT_L(0); PG8_MMA(0, 0, At, B0); PG8_BAR; PG8_SCHED;
            PG8_LDB(B1, 0, 1); PG8_STAGE(PG8_SB(0, 0), b2, voffB);
            PG8_BAR; PG8_WAIT_L(0); PG8_MMA(0, 1, At, B1); PG8_BAR;
            PG8_LDA(At, 0, 1); PG8_STAGE(PG8_SA(0, 0), a2, voffA);
            PG8_BAR; PG8_WAIT_L(0); PG8_MMA(1, 0, At, B0); PG8_BAR; PG8_SCHED;
            PG8_STAGE(PG8_SB(0, 1), b2 + hstep, voffB);
            PG8_WAIT_V(6); PG8_BAR; PG8_MMA(1, 1, At, B1); PG8_BAR;
            PG8_LDB(B0, 1, 0); PG8_SCHED; PG8_LDA(At, 1, 0); PG8_STAGE(PG8_SA(0, 1), a2 + hstep, voffA);
            PG8_WAIT_L(8); PG8_BAR; PG8_WAIT_L(0); PG8_MMA(0, 0, At, B0); PG8_BAR; PG8_SCHED;
            PG8_LDB(B1, 1, 1); PG8_STAGE(PG8_SB(1, 0), b3, voffB);
            PG8_BAR; PG8_WAIT_L(0); PG8_MMA(0, 1, At, B1); PG8_BAR;
            PG8_LDA(At, 1, 1); PG8_STAGE(PG8_SA(1, 0), a3, voffA);
            PG8_BAR; PG8_WAIT_L(0); PG8_MMA(1, 0, At, B0); PG8_BAR; PG8_SCHED;
            PG8_STAGE(PG8_SB(1, 1), b3 + hstep, voffB);
            PG8_WAIT_V(6); PG8_BAR; PG8_MMA(1, 1, At, B1); PG8_BAR;
        }
        PG8_STAMP();
        if constexpr (!Epi::AFTER_DRAIN) { E(acc, cur, wr, wc, fr, fq); S.done(cur); }
        PG8_STAMP();
        if (!has_next) break;
#pragma unroll
        for (int a = 0; a < 2; ++a)
#pragma unroll
            for (int b = 0; b < 2; ++b)
#pragma unroll
                for (int m = 0; m < 4; ++m)
#pragma unroll
                    for (int n = 0; n < 2; ++n) acc[a][b][m][n] = (f32x4){0.f, 0.f, 0.f, 0.f};
        cur = nxt; cA = nA; cB = nB; ++ui;
    }
    PG8_WAIT_V(0);
    if (wr == 0) PG8_BAR;
    PG8_BAR;
    if constexpr (Epi::AFTER_DRAIN) { E.fused(acc, cur, wr, wc, fr, fq, lds, wid, lane); S.done(cur); }
    PG8_STAMP();
    if (STAMP && wid == 0) { stamps[lane] = lane < nts ? (((unsigned long long)(unsigned)ts_hi << 32) | (unsigned)ts_lo) : 0ull;
        if (lane == 62) stamps[62] = rt_entry; if (lane == 63) stamps[63] = (unsigned long long)wall_clock64(); }
#undef PG8_STAMP
#undef PG8_SA
#undef PG8_SB
#undef PG8_STAGE
#undef PG8_LDA
#undef PG8_LDB
#undef PG8_MMA
#undef PG8_WAIT_V
#undef PG8_WAIT_L
#undef PG8_BAR
#undef PG8_SCHED
}
}
namespace cg = cooperative_groups;
__device__ __forceinline__ int otid() { int t = threadIdx.x; asm volatile("" : "+v"(t)); return t; }
__device__ __forceinline__ int obid() { int b = blockIdx.x; asm volatile("" : "+s"(b)); return b; }
typedef unsigned short u16;
using pg8::bf16x8; using pg8::f32x4;
typedef unsigned u32x4v __attribute__((ext_vector_type(4)));
typedef unsigned u32x2v __attribute__((ext_vector_type(2)));
typedef float f32x4v __attribute__((ext_vector_type(4)));

constexpr int NTOK = 65536, DM = 1024, DFF = 2816;
constexpr int EVC = 3840, ODC = 4608;
constexpr float ALPHA_F = 1.681792830507429f;
constexpr int HALF_ROWS = 32768, Q_ROWS = 16384;

constexpr size_t SZ_FFN_IN = (size_t)5632 * 1024 * 2, SZ_FFN_OUT = (size_t)1024 * 2816 * 2;
constexpr size_t SZ_EV_IN = (size_t)EVC * 1024 * 2, SZ_OD_IN = (size_t)ODC * 1024 * 2, SZ_SQ = (size_t)1024 * 1024 * 2;
constexpr size_t WS_FFN_IN = 0;
constexpr size_t WS_FFN_OUT = WS_FFN_IN + 8 * SZ_FFN_IN;
constexpr size_t WS_EV_IN = WS_FFN_OUT + 8 * SZ_FFN_OUT;
constexpr size_t WS_OD_IN = WS_EV_IN + 2 * SZ_EV_IN;
constexpr size_t WS_EV_OUT = WS_OD_IN + 2 * SZ_OD_IN;
constexpr size_t WS_OD_OUT = WS_EV_OUT + 2 * SZ_SQ;
constexpr size_t WS_XB = WS_OD_OUT + 2 * SZ_SQ;
constexpr size_t WS_ROPE = WS_XB + (size_t)NTOK * DM * 2;
constexpr size_t WS_SCR = WS_ROPE + 4096;
constexpr size_t SZ_Y = (size_t)Q_ROWS * ODC * 2;
constexpr size_t SZ_ST = (size_t)256 * 16 * 16384 * 2;
constexpr size_t SZ_DEC = (size_t)256 * 16 * 128 * 4;
constexpr size_t SZ_NV = (size_t)256 * 8 * 128 * 4;
constexpr size_t WS_Y = WS_SCR, WS_ST = WS_Y + SZ_Y, WS_DEC = WS_ST + SZ_ST, WS_NV = WS_DEC + SZ_DEC, WS_END = WS_NV + SZ_NV;
constexpr size_t WS_ACT = WS_SCR;

struct Params {
    const float* in[19];
    float* X;
    unsigned char* ws;
};

__device__ __forceinline__ float bf2f(u16 b) { return __uint_as_float(((unsigned)b) << 16); }
__device__ __forceinline__ u16 f2bf(float f) { unsigned u = __float_as_uint(f); u += 0x7FFFu + ((u >> 16) & 1u); return (u16)(u >> 16); }
__device__ __forceinline__ unsigned pk2(float lo, float hi) { return (unsigned)f2bf(lo) | ((unsigned)f2bf(hi) << 16); }
__device__ __forceinline__ float sigmoidf_(float x) { return 1.0f / (1.0f + __expf(-x)); }
__device__ __forceinline__ float siluf_(float x) { return x / (1.0f + __expf(-x)); }
__device__ __forceinline__ float logsigf_(float x) { return fminf(x, 0.f) - log1pf(__expf(-fabsf(x))); }
__device__ __forceinline__ float expc(float x) { return __expf(fminf(x, 80.f)); }
__device__ __forceinline__ void load16(const u16* p, float* o) {
    const u32x4v a = *(const u32x4v*)p, b = *(const u32x4v*)(p + 8);
#pragma unroll
    for (int i = 0; i < 4; ++i) { o[2 * i] = __uint_as_float(a[i] << 16); o[2 * i + 1] = __uint_as_float(a[i] & 0xffff0000u);
                                  o[8 + 2 * i] = __uint_as_float(b[i] << 16); o[8 + 2 * i + 1] = __uint_as_float(b[i] & 0xffff0000u); }
}
__device__ __forceinline__ void store16(u16* p, const float* v) {
    u32x4v a, b;
#pragma unroll
    for (int i = 0; i < 4; ++i) { a[i] = pk2(v[2 * i], v[2 * i + 1]); b[i] = pk2(v[8 + 2 * i], v[8 + 2 * i + 1]); }
    *(u32x4v*)p = a; *(u32x4v*)(p + 8) = b;
}

struct EpiSwiGLU {
    static constexpr bool PERM = true, AFTER_DRAIN = false;
    u16* O; int ldc;
    __device__ __forceinline__ void operator()(const f32x4 (&acc)[2][2][4][2], const pg8::Unit& u, int wr, int wc, int fr, int fq) const {
        const int row0 = u.pm * 256 + wr * 64 + fr, col0 = u.pn * 128 + wc * 32 + 8 * fq;
#pragma unroll
        for (int ai = 0; ai < 2; ++ai)
#pragma unroll
            for (int m = 0; m < 4; ++m) {
                u16* dst = O + (size_t)(row0 + ai * 128 + m * 16) * ldc + col0;
                float v[8];
#pragma unroll
                for (int n = 0; n < 2; ++n)
#pragma unroll
                    for (int j = 0; j < 4; ++j) { const float g = acc[ai][0][m][n][j], uu = acc[ai][1][m][n][j]; v[4 * n + j] = siluf_(g) * uu; }
                u32x4v o; o[0] = pk2(v[0], v[1]); o[1] = pk2(v[2], v[3]); o[2] = pk2(v[4], v[5]); o[3] = pk2(v[6], v[7]);
                *(u32x4v*)dst = o;
            }
    }
};
struct EpiBf16 {
    static constexpr bool PERM = true, AFTER_DRAIN = false;
    u16* O; int ldc;
    __device__ __forceinline__ void operator()(const f32x4 (&acc)[2][2][4][2], const pg8::Unit& u, int wr, int wc, int fr, int fq) const {
        const int row0 = u.pm * 256 + wr * 64 + fr, col0 = u.pn * 256 + wc * 32 + 8 * fq;
#pragma unroll
        for (int ai = 0; ai < 2; ++ai)
#pragma unroll
            for (int m = 0; m < 4; ++m)
#pragma unroll
                for (int bj = 0; bj < 2; ++bj) {
                    u16* dst = O + (size_t)(row0 + ai * 128 + m * 16) * ldc + col0 + bj * 128;
                    const f32x4 a = acc[ai][bj][m][0], b = acc[ai][bj][m][1];
                    u32x4v o; o[0] = pk2(a[0], a[1]); o[1] = pk2(a[2], a[3]); o[2] = pk2(b[0], b[1]); o[3] = pk2(b[2], b[3]);
                    *(u32x4v*)dst = o;
                }
    }
};
struct EpiResid {
    static constexpr bool PERM = false, AFTER_DRAIN = false;
    float* X; float scale;
    __device__ __forceinline__ void operator()(const f32x4 (&acc)[2][2][4][2], const pg8::Unit& u, int wr, int wc, int fr, int fq) const {
        const int row0 = u.pm * 256 + wr * 64 + fr, col0 = u.pn * 256 + wc * 32 + 4 * fq;
#pragma unroll
        for (int ai = 0; ai < 2; ++ai)
#pragma unroll
            for (int m = 0; m < 4; ++m) {
                float* rowp = X + (size_t)(row0 + ai * 128 + m * 16) * DM + col0;
                __builtin_amdgcn_sched_barrier(0);
#pragma unroll
                for (int bj = 0; bj < 2; ++bj)
#pragma unroll
                    for (int n = 0; n < 2; ++n) {
                        f32x4v* q = (f32x4v*)(rowp + bj * 128 + n * 16);
                        const f32x4v old = *q; const f32x4 a = acc[ai][bj][m][n];
                        f32x4v r; r[0] = ALPHA_F * old[0] + scale * a[0]; r[1] = ALPHA_F * old[1] + scale * a[1]; r[2] = ALPHA_F * old[2] + scale * a[2]; r[3] = ALPHA_F * old[3] + scale * a[3];
                        *q = r;
                    }
            }
    }
};

template <class Epi>
__device__ __forceinline__ void run_gemm(unsigned char* shm, const u16* A, const u16* Bt, int M, int N, int K, const Epi& E) {
    pg8::Gemm g; g.A = A; g.Bt = Bt; g.M = M; g.N = N; g.K = K;
    pg8::StaticOrder S; S.init(M, N, (int)gridDim.x, obid());
    pg8::gemm_phase<Epi, pg8::StaticOrder, false>((PG8_LAS unsigned char*)shm, g, S, E, nullptr);
    __syncthreads();
}

__device__ __forceinline__ void transpose_tile(unsigned char* shm, const float* src, int K, int Nsrc, u16* dst, int r0, int n0, int k0) {
    float* tile = (float*)shm;
    const int tid = otid();
    {
        const int r = tid >> 4, c4 = (tid & 15) * 4;
#pragma unroll
        for (int i = 0; i < 2; ++i) {
            const int k = r + 32 * i;
            f32x4v v = {0.f, 0.f, 0.f, 0.f};
            if (n0 + c4 < Nsrc) v = *(const f32x4v*)(src + (size_t)(k0 + k) * Nsrc + n0 + c4);
            tile[k * 65 + c4 + 0] = v[0]; tile[k * 65 + c4 + 1] = v[1]; tile[k * 65 + c4 + 2] = v[2]; tile[k * 65 + c4 + 3] = v[3];
        }
    }
    __syncthreads();
    {
        const int n = tid >> 3, kg = (tid & 7) * 8;
        float v[8];
#pragma unroll
        for (int j = 0; j < 8; ++j) v[j] = tile[(kg + j) * 65 + n];
        u32x4v o; o[0] = pk2(v[0], v[1]); o[1] = pk2(v[2], v[3]); o[2] = pk2(v[4], v[5]); o[3] = pk2(v[6], v[7]);
        *(u32x4v*)(dst + (size_t)(r0 + n) * K + k0 + kg) = o;
    }
    __syncthreads();
}

__device__ void phase_prep(const Params& p, unsigned char* shm) {
    const int tid = otid();
    u16* XB = (u16*)(p.ws + WS_XB);
    {
        const size_t n4 = (size_t)NTOK * DM / 4, half4 = n4 / 2;
        for (size_t i = (size_t)blockIdx.x * 512 + tid; i < n4; i += (size_t)gridDim.x * 512) {
            const f32x4v v = (i < half4) ? ((const f32x4v*)p.in[0])[i] : ((const f32x4v*)p.in[1])[i - half4];
            ((f32x4v*)p.X)[i] = v;
            u32x2v o; o[0] = pk2(v[0], v[1]); o[1] = pk2(v[2], v[3]);
            ((u32x2v*)XB)[i] = o;
        }
    }
    if (blockIdx.x == 0 && tid < 64) {
        double* rope = (double*)(p.ws + WS_ROPE);
        rope[tid] = exp2(-(double)tid / 64.0 * 13.287712379549449) / 6.283185307179586;
    }
    const int T_FI = 88 * 16, T_FO = 16 * 44, T_EI = 60 * 16, T_OI = 72 * 16, T_SQ = 16 * 16;
    const int total = 8 * T_FI + 8 * T_FO + 2 * T_EI + 2 * T_OI + 4 * T_SQ;
    for (int u = blockIdx.x; u < total; u += gridDim.x) {
        int r = u;
        if (r < 8 * T_FI) {
            const int mi = r / T_FI, ti = r % T_FI, which = mi >> 2, l = mi & 3;
            const float* src = p.in[which ? 4 : 2] + (size_t)l * 1024 * 5632;
            u16* dst = (u16*)(p.ws + WS_FFN_IN + (size_t)mi * SZ_FFN_IN);
            const int rt = ti >> 4, kt = ti & 15;
            const int r0 = rt * 64, pn = r0 >> 8, hh = (r0 >> 7) & 1, jj = (r0 >> 6) & 1;
            transpose_tile(shm, src, 1024, 5632, dst, r0, hh * 2816 + pn * 128 + jj * 64, kt * 64);
            continue;
        }
        r -= 8 * T_FI;
        if (r < 8 * T_FO) {
            const int mi = r / T_FO, ti = r % T_FO, which = mi >> 2, l = mi & 3;
            const float* src = p.in[which ? 5 : 3] + (size_t)l * 2816 * 1024;
            u16* dst = (u16*)(p.ws + WS_FFN_OUT + (size_t)mi * SZ_FFN_OUT);
            const int rt = ti / 44, kt = ti % 44;
            transpose_tile(shm, src, 2816, 1024, dst, rt * 64, rt * 64, kt * 64);
            continue;
        }
        r -= 8 * T_FO;
        if (r < 2 * T_EI) {
            const int j = r / T_EI, ti = r % T_EI;
            const float* src = p.in[8] + (size_t)j * 1024 * 3632;
            u16* dst = (u16*)(p.ws + WS_EV_IN + (size_t)j * SZ_EV_IN);
            const int rt = ti >> 4, kt = ti & 15;
            transpose_tile(shm, src, 1024, 3632, dst, rt * 64, rt * 64, kt * 64);
            continue;
        }
        r -= 2 * T_EI;
        if (r < 2 * T_OI) {
            const int j = r / T_OI, ti = r % T_OI;
            const float* src = p.in[15] + (size_t)j * 1024 * 4608;
            u16* dst = (u16*)(p.ws + WS_OD_IN + (size_t)j * SZ_OD_IN);
            const int rt = ti >> 4, kt = ti & 15;
            transpose_tile(shm, src, 1024, 4608, dst, rt * 64, rt * 64, kt * 64);
            continue;
        }
        r -= 2 * T_OI;
        {
            const int mi = r / T_SQ, ti = r % T_SQ;
            const float* src = p.in[mi < 2 ? 14 : 18] + (size_t)(mi & 1) * 1024 * 1024;
            u16* dst = (u16*)(p.ws + (mi < 2 ? WS_EV_OUT : WS_OD_OUT) + (size_t)(mi & 1) * SZ_SQ);
            const int rt = ti >> 4, kt = ti & 15;
            transpose_tile(shm, src, 1024, 1024, dst, rt * 64, rt * 64, kt * 64);
        }
    }
}

__device__ void phase_ln(const Params& p, const float* g, const float* b) {
    const int tid = otid(); const int lane = tid & 63, w = tid >> 6;
    u16* XB = (u16*)(p.ws + WS_XB);
    f32x4v gv[4], bv[4];
#pragma unroll
    for (int i = 0; i < 4; ++i) { gv[i] = *(const f32x4v*)(g + 4 * lane + 256 * i); bv[i] = *(const f32x4v*)(b + 4 * lane + 256 * i); }
    for (int row = blockIdx.x * 8 + w; row < NTOK; row += gridDim.x * 8) {
        float* xr = p.X + (size_t)row * DM;
        f32x4v v[4];
#pragma unroll
        for (int i = 0; i < 4; ++i) v[i] = *(const f32x4v*)(xr + 4 * lane + 256 * i);
        float s = 0.f;
#pragma unroll
        for (int i = 0; i < 4; ++i) s += v[i][0] + v[i][1] + v[i][2] + v[i][3];
#pragma unroll
        for (int o = 32; o >= 1; o >>= 1) s += __shfl_xor(s, o);
        const float mu = s * (1.0f / 1024.0f);
        float q = 0.f;
#pragma unroll
        for (int i = 0; i < 4; ++i)
#pragma unroll
            for (int j = 0; j < 4; ++j) { const float d = v[i][j] - mu; q += d * d; }
#pragma unroll
        for (int o = 32; o >= 1; o >>= 1) q += __shfl_xor(q, o);
        const float rs = rsqrtf(q * (1.0f / 1024.0f) + 1e-5f);
#pragma unroll
        for (int i = 0; i < 4; ++i) {
            f32x4v o4;
#pragma unroll
            for (int j = 0; j < 4; ++j) o4[j] = (v[i][j] - mu) * rs * gv[i][j] + bv[i][j];
            *(f32x4v*)(xr + 4 * lane + 256 * i) = o4;
            u32x2v o2; o2[0] = pk2(o4[0], o4[1]); o2[1] = pk2(o4[2], o4[3]);
            *(u32x2v*)(XB + (size_t)row * DM + 4 * lane + 256 * i) = o2;
        }
    }
}

constexpr int QS = 136, VS = 130, BS = 132, PS = 72;
constexpr int OFF_QN = 0;
constexpr int OFF_KN = OFF_QN + 64 * QS * 2;
constexpr int OFF_VG = OFF_KN + 64 * QS * 2;
constexpr int OFF_B = OFF_VG + 64 * VS * 2;
constexpr int OFF_QS = OFF_B + 64 * BS * 4;
constexpr int OFF_KS = OFF_QS + 64 * QS * 2;
constexpr int OFF_QI = OFF_KS + 64 * QS * 2;
constexpr int OFF_P = OFF_QI + 64 * QS * 2;
constexpr int OFF_MISC = OFF_P + 64 * PS * 2;
constexpr int SCAN_LDS = OFF_MISC + 9216;
static_assert(SCAN_LDS <= 160 * 1024, "lds");
static_assert((OFF_B % 16) == 0 && (OFF_QS % 16) == 0 && (OFF_P % 16) == 0 && (OFF_MISC % 16) == 0, "align");

struct ScanCtx {
    const u16* Y; int ld;
    u16* H;
    u16* ST; float* DEC; float* NV;
    int cps;
    int even;
    int j;
    const float *gate_b, *conv_w, *a2_w, *a2_b, *norm_w, *lb_logits;
    const double* rope;
};

template <int MODE>
__device__ void scan_unit(const ScanCtx& cx, int c, int head, unsigned char* lds) {
    const int tid = otid(), lane = tid & 63, w = tid >> 6;
    const int h = head & 3, mix = (cx.even ? 0 : 2) + (head >> 2);
    const int dk = (mix == 1) ? 64 : 128;
    const bool scalar = (mix == 0 || mix == 3);
    u16* Qn = (u16*)(lds + OFF_QN); u16* Kn = (u16*)(lds + OFF_KN); u16* Vg = (u16*)(lds + OFF_VG);
    float* Bm = (float*)(lds + OFF_B);
    u16* Qs = (u16*)(lds + OFF_QS); u16* Ks = (u16*)(lds + OFF_KS); u16* Qi = (u16*)(lds + OFF_QI); u16* Pm = (u16*)(lds + OFF_P);
    float* GT = (float*)(lds + OFF_MISC);
    float* RED = GT + 256;
    float* NPREV = RED + 1024;
    float* DEN = NPREV + 128;
    float* SEG = DEN + 64;
    float* STAT = SEG + 512;
    const int t = tid >> 3, g = tid & 7, d0 = g * 16;
    const int cs = c % cx.cps;
    const size_t row0 = (size_t)c * 64;
    const int ld = cx.ld;
    const u16* Yr = cx.Y + (row0 + t) * ld;
    const int lr = lane & 15, lq = lane >> 4;

    if (mix == 0) {
#pragma unroll 1
        for (int which = 0; which < 2; ++which) {
            const int ch0 = which * 512 + h * 128 + d0;
            float acc[16];
#pragma unroll
            for (int i = 0; i < 16; ++i) acc[i] = 0.f;
#pragma unroll 1
            for (int jt = 0; jt < 5; ++jt) {
                const int tt = cs * 64 + t + jt - 2;
                if (tt >= 0 && tt < cx.cps * 64) {
                    float xv[16]; load16(cx.Y + (row0 + t + jt - 2) * ld + ch0, xv);
                    const float* wj = cx.conv_w + jt * 1024 + ch0;
#pragma unroll
                    for (int i = 0; i < 16; ++i) acc[i] += xv[i] * wj[i];
                }
            }
            const float sc = which ? 0.08838834764831845f : 1.0f;
#pragma unroll
            for (int i = 0; i < 16; ++i) acc[i] = siluf_(acc[i]) * sc;
            store16((which ? Kn : Qn) + t * QS + d0, acc);
        }
        { float xv[16]; load16(Yr + 1024 + h * 128 + d0, xv);
#pragma unroll
          for (int i = 0; i < 8; ++i) *(unsigned*)(Vg + t * VS + d0 + 2 * i) = pk2(xv[2 * i], xv[2 * i + 1]); }
        if (tid < 64) {
            const u16* yr = cx.Y + (row0 + tid) * ld + 2048;
            const float r0 = bf2f(yr[0 + h]) + cx.gate_b[0 + h], r1 = bf2f(yr[4 + h]) + cx.gate_b[4 + h];
            const float r2 = bf2f(yr[8 + h]) + cx.gate_b[8 + h], r3 = bf2f(yr[12 + h]) + cx.gate_b[12 + h];
            GT[0 * 64 + tid] = r0; GT[1 * 64 + tid] = logsigf_(r1); GT[2 * 64 + tid] = r2; GT[3 * 64 + tid] = logsigf_(r3);
        }
    } else if (mix == 1) {
        float xv[16];
        if (g < 4) { load16(Yr + 2064 + h * 64 + d0, xv);
#pragma unroll
            for (int i = 0; i < 16; ++i) xv[i] *= 0.125f;
            store16(Qn + t * QS + d0, xv); }
        else { load16(Yr + 2320 + h * 64 + (d0 - 64), xv); store16(Kn + t * QS + (d0 - 64), xv); }
        load16(Yr + 2576 + h * 128 + d0, xv);
#pragma unroll
        for (int i = 0; i < 8; ++i) *(unsigned*)(Vg + t * VS + d0 + 2 * i) = pk2(xv[2 * i], xv[2 * i + 1]);
    } else if (mix == 2) {
        float xv[16];
        load16(Yr + 0 + h * 128 + d0, xv);
#pragma unroll
        for (int i = 0; i < 16; ++i) xv[i] = siluf_(xv[i]) * 0.08838834764831845f;
        store16(Qn + t * QS + d0, xv);
        load16(Yr + 1536 + h * 128 + d0, xv);
#pragma unroll
        for (int i = 0; i < 8; ++i) *(unsigned*)(Vg + t * VS + d0 + 2 * i) = pk2(xv[2 * i], xv[2 * i + 1]);
    } else {
        const int gg = g & 3, isk = g >> 2;
        const u16* src = Yr + (isk ? 3072 : 2560) + h * 128;
        float x1[16], x2[16], o1[16], o2[16];
        load16(src + gg * 16, x1); load16(src + 64 + gg * 16, x2);
        const double pos = (double)(cs * 64 + t);
        const float sc = isk ? 0.08838834764831845f : 1.0f;
#pragma unroll
        for (int i = 0; i < 16; ++i) {
            const double tr = pos * cx.rope[gg * 16 + i];
            const float fr = (float)(tr - rint(tr));
            const float sn = __builtin_amdgcn_sinf(fr), cn = __builtin_amdgcn_cosf(fr);
            o1[i] = (x1[i] * cn - x2[i] * sn) * sc; o2[i] = (x1[i] * sn + x2[i] * cn) * sc;
        }
        u16* dstp = (isk ? Kn : Qn) + t * QS;
        store16(dstp + gg * 16, o1); store16(dstp + 64 + gg * 16, o2);
        float xv[16]; load16(Yr + 3584 + h * 128 + d0, xv);
#pragma unroll
        for (int i = 0; i < 8; ++i) *(unsigned*)(Vg + t * VS + d0 + 2 * i) = pk2(xv[2 * i], xv[2 * i + 1]);
    }
    __syncthreads();

    f32x4 acc_tot[4];
#pragma unroll
    for (int i = 0; i < 4; ++i) acc_tot[i] = (f32x4){0.f, 0.f, 0.f, 0.f};

#pragma unroll 1
    for (int dir = 0; dir < 2; ++dir) {
        if (mix == 1) {
            const int dd0 = g * 8;
            float ba[16]; load16(Yr + 3600 + dir * 16, ba);
            const float* w2 = cx.a2_w + (size_t)dir * 16 * 256 + h * 64 + dd0;
            const float* b2 = cx.a2_b + dir * 256 + h * 64 + dd0;
            float a[8];
#pragma unroll
            for (int i = 0; i < 8; ++i) a[i] = b2[i];
#pragma unroll
            for (int r = 0; r < 16; ++r)
#pragma unroll
                for (int i = 0; i < 8; ++i) a[i] += ba[r] * w2[r * 256 + i];
#pragma unroll
            for (int i = 0; i < 8; ++i) Bm[t * BS + dd0 + i] = logsigf_(a[i]) * 0.0625f;
        } else if (mix == 2) {
            float z[16], kk[16];
            load16(Yr + (dir ? 1024 : 512) + h * 128 + d0, z);
#pragma unroll
            for (int i = 0; i < 16; ++i) {
                float lb = 0.f;
                if (cx.j > 0) {
                    const float l0 = cx.lb_logits[0 * 1024 + dir * 512 + h * 128 + d0 + i], l1 = cx.lb_logits[1 * 1024 + dir * 512 + h * 128 + d0 + i];
                    lb = sigmoidf_(l1 - l0);
                }
                const float sg = sigmoidf_(z[i]);
                const float f = lb + (1.f - lb) * sg;
                Bm[t * BS + d0 + i] = __logf(fmaxf(f, 1e-30f));
                kk[i] = (1.f - lb) * sigmoidf_(-z[i]);
            }
            store16(Kn + t * QS + d0, kk);
        }
        __syncthreads();
        if (scalar) {
            if (w == 0) {
                float v = (mix == 0) ? GT[(1 + 2 * dir) * 64 + lane] : log1pf(-exp2f(-5.0f - (float)h));
                if (dir == 0) {
#pragma unroll
                    for (int o = 1; o < 64; o <<= 1) { const float n = __shfl_up(v, o); if (lane >= o) v += n; }
                } else {
#pragma unroll
                    for (int o = 1; o < 64; o <<= 1) { const float n = __shfl_down(v, o); if (lane + o < 64) v += n; }
                }
                Bm[lane * BS] = v;
            }
        } else {
            const int d = tid & 127, sg = tid >> 7;
            if (d < dk) {
                float run = 0.f;
                if (dir == 0) { for (int i = 0; i < 16; ++i) { const int tt = sg * 16 + i; run += Bm[tt * BS + d]; Bm[tt * BS + d] = run; } }
                else { for (int i = 15; i >= 0; --i) { const int tt = sg * 16 + i; run += Bm[tt * BS + d]; Bm[tt * BS + d] = run; } }
                SEG[sg * 128 + d] = run;
            }
            __syncthreads();
            if (d < dk) {
                float off = 0.f;
                if (dir == 0) { for (int s2 = 0; s2 < sg; ++s2) off += SEG[s2 * 128 + d]; }
                else { for (int s2 = 3; s2 > sg; --s2) off += SEG[s2 * 128 + d]; }
                for (int i = 0; i < 16; ++i) Bm[(sg * 16 + i) * BS + d] += off;
            }
        }
        __syncthreads();

        const int tend = dir ? 0 : 63;
        const int hd = head * 2 + dir;
        const size_t slot = (size_t)c * 16 + hd;
        if (MODE == 0) {
            u16* Kg = Ks;
            if (d0 < dk) {
                float kv[16]; load16(Kn + t * QS + d0, kv);
                const float li = (mix == 0) ? GT[(2 * dir) * 64 + t] : 0.f;
#pragma unroll
                for (int i = 0; i < 16; ++i) {
                    const int bi = scalar ? 0 : (d0 + i);
                    kv[i] *= expc(Bm[tend * BS + bi] - Bm[t * BS + bi] + li);
                }
#pragma unroll
                for (int i = 0; i < 8; ++i) *(unsigned*)(Kg + t * VS + d0 + 2 * i) = pk2(kv[2 * i], kv[2 * i + 1]);
            }
            if (tid < 128) cx.DEC[slot * 128 + tid] = __expf(Bm[tend * BS + (scalar ? 0 : (tid < dk ? tid : 0))]);
            __syncthreads();
            if (mix == 0 && tid < 128) {
                float s = 0.f;
                for (int s2 = 0; s2 < 64; ++s2) s += bf2f(Kg[s2 * VS + tid]);
                cx.NV[((size_t)c * 8 + h * 2 + dir) * 128 + tid] = s;
            }
            bf16x8 vb[2];
#pragma unroll
            for (int kk = 0; kk < 2; ++kk)
#pragma unroll
                for (int jx = 0; jx < 8; ++jx) vb[kk][jx] = (short)Vg[(32 * kk + 8 * lq + jx) * VS + 16 * w + lr];
            u16* Sd = cx.ST + slot * 16384;
#pragma unroll 1
            for (int di = 0; di < dk / 16; ++di) {
                f32x4 a4 = (f32x4){0.f, 0.f, 0.f, 0.f};
#pragma unroll
                for (int kk = 0; kk < 2; ++kk) {
                    bf16x8 af;
#pragma unroll
                    for (int jx = 0; jx < 8; ++jx) af[jx] = (short)Kg[(32 * kk + 8 * lq + jx) * VS + 16 * di + lr];
                    a4 = __builtin_amdgcn_mfma_f32_16x16x32_bf16(af, vb[kk], a4, 0, 0, 0);
                }
                u32x2v o; o[0] = pk2(a4[0], a4[1]); o[1] = pk2(a4[2], a4[3]);
                *(u32x2v*)(Sd + (16 * w + lr) * 128 + 16 * di + 4 * lq) = o;
            }
            __syncthreads();
        } else {
            const int tmid = 32;
            if (d0 < dk) {
                float qv[16], kv[16], a[16], bb[16], cc[16];
                load16(Qn + t * QS + d0, qv); load16(Kn + t * QS + d0, kv);
                const float li = (mix == 0) ? GT[(2 * dir) * 64 + t] : 0.f;
#pragma unroll
                for (int i = 0; i < 16; ++i) {
                    const int bi = scalar ? 0 : (d0 + i);
                    const float b = Bm[t * BS + bi], bm = Bm[tmid * BS + bi];
                    a[i] = qv[i] * expc(b - bm);
                    bb[i] = kv[i] * expc(bm - b + li);
                    cc[i] = qv[i] * __expf(b);
                }
                store16(Qs + t * QS + d0, a); store16(Ks + t * QS + d0, bb); store16(Qi + t * QS + d0, cc);
            }
            if (mix == 0 && tid < 128) NPREV[tid] = cx.NV[((size_t)c * 8 + h * 2 + dir) * 128 + tid];
            __syncthreads();
            {
                const int ti = w >> 1, tj0 = 2 * (w & 1);
                f32x4 sc[2] = {(f32x4){0.f, 0.f, 0.f, 0.f}, (f32x4){0.f, 0.f, 0.f, 0.f}};
                for (int kk = 0; kk < dk / 32; ++kk) {
                    const bf16x8 af = *(const bf16x8*)(Qs + (16 * ti + lr) * QS + 32 * kk + 8 * lq);
#pragma unroll
                    for (int jj = 0; jj < 2; ++jj) {
                        const bf16x8 bfr = *(const bf16x8*)(Ks + (16 * (tj0 + jj) + lr) * QS + 32 * kk + 8 * lq);
                        sc[jj] = __builtin_amdgcn_mfma_f32_16x16x32_bf16(af, bfr, sc[jj], 0, 0, 0);
                    }
                }
#pragma unroll
                for (int jj = 0; jj < 2; ++jj)
#pragma unroll
                    for (int r = 0; r < 4; ++r) {
                        const int tt = 16 * ti + 4 * lq + r, ss = 16 * (tj0 + jj) + lr;
                        const bool keep = dir ? (ss >= tt) : (ss <= tt);
                        Pm[tt * PS + ss] = f2bf(keep ? sc[jj][r] : 0.f);
                    }
            }
            __syncthreads();
            if (mix == 0) {
                float v = 0.f;
#pragma unroll
                for (int i = 0; i < 8; ++i) v += bf2f(Pm[t * PS + 8 * g + i]);
#pragma unroll
                for (int i = 0; i < 16; ++i) v += bf2f(Qi[t * QS + d0 + i]) * NPREV[d0 + i];
                v += __shfl_xor(v, 1); v += __shfl_xor(v, 2); v += __shfl_xor(v, 4);
                if (g == 0) DEN[t] = v;
            }
            f32x4 ad[4];
#pragma unroll
            for (int i = 0; i < 4; ++i) ad[i] = (f32x4){0.f, 0.f, 0.f, 0.f};
#pragma unroll
            for (int kk = 0; kk < 2; ++kk) {
                bf16x8 vb;
#pragma unroll
                for (int jx = 0; jx < 8; ++jx) vb[jx] = (short)Vg[(32 * kk + 8 * lq + jx) * VS + 16 * w + lr];
#pragma unroll
                for (int ti = 0; ti < 4; ++ti) {
                    const bf16x8 af = *(const bf16x8*)(Pm + (16 * ti + lr) * PS + 32 * kk + 8 * lq);
                    ad[ti] = __builtin_amdgcn_mfma_f32_16x16x32_bf16(af, vb, ad[ti], 0, 0, 0);
                }
            }
            {
                const u16* Sg = cx.ST + slot * 16384;
                for (int kk = 0; kk < dk / 32; ++kk) {
                    const bf16x8 sb = *(const bf16x8*)(Sg + (16 * w + lr) * 128 + 32 * kk + 8 * lq);
#pragma unroll
                    for (int ti = 0; ti < 4; ++ti) {
                        const bf16x8 af = *(const bf16x8*)(Qi + (16 * ti + lr) * QS + 32 * kk + 8 * lq);
                        ad[ti] = __builtin_amdgcn_mfma_f32_16x16x32_bf16(af, sb, ad[ti], 0, 0, 0);
                    }
                }
            }
            if (mix == 0) {
                __syncthreads();
#pragma unroll
                for (int ti = 0; ti < 4; ++ti)
#pragma unroll
                    for (int r = 0; r < 4; ++r) { const float dn = fmaxf(fabsf(DEN[16 * ti + 4 * lq + r]), 1.0f); acc_tot[ti][r] += ad[ti][r] / dn; }
            } else {
#pragma unroll
                for (int ti = 0; ti < 4; ++ti) acc_tot[ti] += ad[ti];
            }
            __syncthreads();
        }
    }

    if (MODE == 1) {
#pragma unroll
        for (int ti = 0; ti < 4; ++ti)
#pragma unroll
            for (int r = 0; r < 4; ++r) {
                float s1 = acc_tot[ti][r], s2 = s1 * s1;
#pragma unroll
                for (int o = 1; o < 16; o <<= 1) { s1 += __shfl_xor(s1, o); s2 += __shfl_xor(s2, o); }
                if (lr == 0) { RED[(w * 64 + 16 * ti + 4 * lq + r) * 2 + 0] = s1; RED[(w * 64 + 16 * ti + 4 * lq + r) * 2 + 1] = s2; }
            }
        __syncthreads();
        if (tid < 64) {
            float s1 = 0.f, s2 = 0.f;
#pragma unroll
            for (int ww = 0; ww < 8; ++ww) { s1 += RED[(ww * 64 + tid) * 2]; s2 += RED[(ww * 64 + tid) * 2 + 1]; }
            const float mean = s1 * (1.f / 128.f), ex2 = s2 * (1.f / 128.f);
            const bool lnorm = (mix == 0 || mix == 3);
            STAT[tid * 2] = lnorm ? mean : 0.f;
            STAT[tid * 2 + 1] = rsqrtf((lnorm ? fmaxf(ex2 - mean * mean, 0.f) : ex2) + 1e-5f);
        }
        __syncthreads();
        const int e = 16 * w + lr;
        int gcol, hcol; float nw = 1.f;
        if (mix == 0) { gcol = 1536 + h * 128 + e; hcol = h * 128 + e; nw = cx.norm_w[h * 128 + e]; }
        else if (mix == 1) { gcol = 3088 + h * 128 + e; hcol = 512 + h * 128 + e; nw = cx.norm_w[512 + h * 128 + e]; }
        else if (mix == 2) { gcol = 2048 + h * 128 + e; hcol = h * 128 + e; nw = cx.norm_w[h * 128 + e]; }
        else { gcol = 4096 + h * 128 + e; hcol = 512 + h * 128 + e; }
#pragma unroll
        for (int ti = 0; ti < 4; ++ti)
#pragma unroll
            for (int r = 0; r < 4; ++r) {
                const int tt = 16 * ti + 4 * lq + r;
                const float xn = (acc_tot[ti][r] - STAT[tt * 2]) * STAT[tt * 2 + 1];
                const float gv = bf2f(cx.Y[(row0 + tt) * ld + gcol]);
                const float gate = (mix == 0) ? sigmoidf_(gv) : siluf_(gv);
                cx.H[(row0 + tt) * DM + hcol] = f2bf(xn * nw * gate);
            }
        __syncthreads();
    }
}

__device__ void phase_scan_prefix(const ScanCtx& cx) {
    const int tid = otid();
    const int nseq = 256 / cx.cps;
    const int nunits = nseq * 16 * 16;
    for (int u = blockIdx.x; u < nunits; u += gridDim.x) {
        const int chain = u >> 4, sub = u & 15;
        const int seq = chain >> 4, hd = chain & 15, head = hd >> 1, dir = hd & 1;
        const int idx = sub * 512 + tid, e = idx >> 6, d = (idx & 63) * 2;
        const int dk = (cx.even && head >= 4) ? 64 : 128;
        const int cbase = seq * cx.cps, n = cx.cps;
        if (d < dk) {
            float s0 = 0.f, s1 = 0.f;
#pragma unroll 1
            for (int i0 = 0; i0 < n; i0 += 8) {
                unsigned wv[8]; float dc0[8], dc1[8];
#pragma unroll
                for (int k = 0; k < 8; ++k) {
                    const int c = dir ? (cbase + n - 1 - (i0 + k)) : (cbase + i0 + k);
                    const size_t slot = (size_t)c * 16 + hd;
                    wv[k] = *(const unsigned*)(cx.ST + slot * 16384 + e * 128 + d);
                    dc0[k] = cx.DEC[slot * 128 + d]; dc1[k] = cx.DEC[slot * 128 + d + 1];
                }
#pragma unroll
                for (int k = 0; k < 8; ++k) {
                    const int c = dir ? (cbase + n - 1 - (i0 + k)) : (cbase + i0 + k);
                    const size_t slot = (size_t)c * 16 + hd;
                    *(unsigned*)(cx.ST + slot * 16384 + e * 128 + d) = pk2(s0, s1);
                    s0 = dc0[k] * s0 + __uint_as_float(wv[k] << 16);
                    s1 = dc1[k] * s1 + __uint_as_float(wv[k] & 0xffff0000u);
                }
            }
        }
        if (cx.even && head < 4 && sub == 0 && tid < 128) {
            float s = 0.f;
#pragma unroll 1
            for (int i = 0; i < n; ++i) {
                const int c = dir ? (cbase + n - 1 - i) : (cbase + i);
                const size_t slot = (size_t)c * 16 + hd;
                float* q = cx.NV + ((size_t)c * 8 + head * 2 + dir) * 128 + tid;
                const float dlt = *q; *q = s;
                s = cx.DEC[slot * 128 + tid] * s + dlt;
            }
        }
    }
}

constexpr int PH_PER_LAYER = 31, N_PHASES = 1 + 4 * PH_PER_LAYER;

__device__ void run_phase(const Params& p, int ph, unsigned char* shm) {
    if (ph == 0) { phase_prep(p, shm); return; }
    const int l = (ph - 1) / PH_PER_LAYER, s = (ph - 1) % PH_PER_LAYER, j = l >> 1, even = !(l & 1);
    u16* XB = (u16*)(p.ws + WS_XB);
    if (s < 5 || s >= 26) {
        const int which = (s >= 26), ss = which ? s - 26 : s;
        if (ss == 4) { phase_ln(p, p.in[6] + (l * 3 + (which ? 2 : 0)) * DM, p.in[7] + (l * 3 + (which ? 2 : 0)) * DM); return; }
        const int half = ss >> 1;
        u16* ACT = (u16*)(p.ws + WS_ACT);
        if ((ss & 1) == 0) {
            EpiSwiGLU E; E.O = ACT; E.ldc = DFF;
            run_gemm(shm, XB + (size_t)half * HALF_ROWS * DM, (const u16*)(p.ws + WS_FFN_IN + (size_t)(which * 4 + l) * SZ_FFN_IN), HALF_ROWS, 5632, 1024, E);
        } else {
            EpiResid E; E.X = p.X + (size_t)half * HALF_ROWS * DM; E.scale = 0.5f;
            run_gemm(shm, ACT, (const u16*)(p.ws + WS_FFN_OUT + (size_t)(which * 4 + l) * SZ_FFN_OUT), HALF_ROWS, 1024, DFF, E);
        }
        return;
    }
    if (s == 25) { phase_ln(p, p.in[6] + (l * 3 + 1) * DM, p.in[7] + (l * 3 + 1) * DM); return; }
    const int q = (s - 5) / 5, k = (s - 5) % 5;
    ScanCtx cx;
    cx.Y = (const u16*)(p.ws + WS_Y); cx.ld = even ? EVC : ODC;
    cx.H = XB + (size_t)q * Q_ROWS * DM;
    cx.ST = (u16*)(p.ws + WS_ST); cx.DEC = (float*)(p.ws + WS_DEC); cx.NV = (float*)(p.ws + WS_NV);
    cx.cps = (q < 2) ? 256 : 64; cx.even = even; cx.j = j;
    cx.gate_b = p.in[9] + j * 16; cx.conv_w = p.in[10] + j * 5 * 1024; cx.a2_w = p.in[11] + (size_t)j * 2 * 16 * 256; cx.a2_b = p.in[12] + j * 2 * 256;
    cx.norm_w = even ? (p.in[13] + j * 1024) : (p.in[17] + j * 512);
    cx.lb_logits = p.in[16];
    cx.rope = (const double*)(p.ws + WS_ROPE);
    if (k == 0) {
        EpiBf16 E; E.O = (u16*)(p.ws + WS_Y); E.ldc = cx.ld;
        const u16* Bt = even ? (const u16*)(p.ws + WS_EV_IN + (size_t)j * SZ_EV_IN) : (const u16*)(p.ws + WS_OD_IN + (size_t)j * SZ_OD_IN);
        run_gemm(shm, XB + (size_t)q * Q_ROWS * DM, Bt, Q_ROWS, cx.ld, 1024, E);
    } else if (k == 1) {
        for (int u = blockIdx.x; u < 2048; u += gridDim.x) scan_unit<0>(cx, u >> 3, u & 7, shm);
    } else if (k == 2) {
        phase_scan_prefix(cx);
    } else if (k == 3) {
        for (int u = blockIdx.x; u < 2048; u += gridDim.x) scan_unit<1>(cx, u >> 3, u & 7, shm);
    } else {
        EpiResid E; E.X = p.X + (size_t)q * Q_ROWS * DM; E.scale = 1.0f;
        const u16* Bt = even ? (const u16*)(p.ws + WS_EV_OUT + (size_t)j * SZ_SQ) : (const u16*)(p.ws + WS_OD_OUT + (size_t)j * SZ_SQ);
        run_gemm(shm, cx.H, Bt, Q_ROWS, 1024, 1024, E);
    }
}

template <bool COOP>
__global__ __launch_bounds__(512, 2) void hybrid_mega(Params p, int ph0, int ph1) {
    extern __shared__ __attribute__((aligned(16))) unsigned char shm[];
    for (int ph = ph0; ph < ph1; ++ph) {
        run_phase(p, ph, shm);
        if (COOP && ph + 1 < ph1) cg::this_grid().sync();
    }
}

#ifndef USE_COOP
#define USE_COOP 1
#endif

extern "C" void kernel_launch(void* const* d_in, const int* in_sizes, int n_in, void* d_out, int out_size, void* d_ws, size_t ws_size, hipStream_t stream) {
    (void)in_sizes; (void)n_in; (void)out_size; (void)ws_size;
    Params p{};
    for (int i = 0; i < 19; ++i) p.in[i] = (const float*)d_in[i];
    p.X = (float*)d_out; p.ws = (unsigned char*)d_ws;
    constexpr size_t kLds = SCAN_LDS > 131072 ? SCAN_LDS : 131072;
#if USE_COOP
    static int grid_blocks = 0;
    if (!grid_blocks) {
        hipFuncSetAttribute((const void*)hybrid_mega<true>, hipFuncAttributeMaxDynamicSharedMemorySize, (int)kLds);
        int dev = 0, cus = 0, per_cu = 0;
        hipGetDevice(&dev);
        hipDeviceGetAttribute(&cus, hipDeviceAttributeMultiprocessorCount, dev);
        hipOccupancyMaxActiveBlocksPerMultiprocessor(&per_cu, hybrid_mega<true>, 512, kLds);
        if (per_cu < 1) per_cu = 1;
        grid_blocks = cus * 1;
    }
    int ph0 = 0, ph1 = N_PHASES;
    void* args[] = {&p, &ph0, &ph1};
    hipLaunchCooperativeKernel((const void*)hybrid_mega<true>, dim3(grid_blocks), dim3(512), args, kLds, stream);
#else
    static int inited = 0;
    if (!inited) { hipFuncSetAttribute((const void*)hybrid_mega<false>, hipFuncAttributeMaxDynamicSharedMemorySize, (int)kLds); inited = 1; }
    for (int ph = 0; ph < N_PHASES; ++ph) hybrid_mega<false><<<256, 512, kLds, stream>>>(p, ph, ph + 1);
#endif
}
```

```cpp
#define PROBE_MASK 0
#include <hip/hip_runtime.h>
#include <hip/hip_cooperative_groups.h>
namespace pg8 {
#define PG8_LAS __attribute__((address_space(3)))
typedef unsigned short bf16_t;
typedef short bf16x8 __attribute__((ext_vector_type(8)));
typedef float f32x4 __attribute__((ext_vector_type(4)));
typedef unsigned u32x4 __attribute__((ext_vector_type(4)));
constexpr int BM = 256, BK = 64, HALF = 128, HTB = HALF * BK * 2  , STAGE_BYTES = 8 * HTB, NXCD = 8, WGM = 8;

__host__ __device__ __forceinline__ int lds_byte(int r, int c) { const int st = (r >> 4) * 2 + (c >> 5), rr = r & 15, cc = c & 31, ob = rr * 64 + cc * 2; return st * 1024 + (ob ^ (((ob >> 9) & 1) << 5)); }
__host__ __device__ __forceinline__ void stage_rc(int b, int& R, int& C) { const int st = b / 1024, sb = b % 1024, swz = sb ^ (((sb >> 9) & 1) << 5); R = (st >> 1) * 16 + swz / 64; C = (st & 1) * 32 + (swz % 64) / 2; }
__host__ __device__ __forceinline__ int perm32(int rho) { const int n = rho >> 4, i = rho & 15; return 8 * (i >> 2) + 4 * n + (i & 3); }

struct Unit { int pm, pn; };
struct Gemm { const bf16_t* A; const bf16_t* Bt; int M, N, K; };

struct StaticOrder {
    int nM, nN, nwg, G, c;
    __host__ __device__ void init(int M, int N, int G_, int c_) { nM = M / BM; nN = N / BM; nwg = nM * nN; G = G_; c = c_; }
    __host__ __device__ bool next(int i, Unit& u) const {
        const long L = (long)i * G + c; if (L >= nwg) return false;
        int wgid = (int)L; { const int q = nwg / NXCD, r = nwg % NXCD, xcd = wgid % NXCD, off = wgid / NXCD; wgid = (xcd < r ? xcd * (q + 1) : r * (q + 1) + (xcd - r) * q) + off; }
        const int nig = WGM * nN, gid = wgid / nig, fm = gid * WGM, gsz = (nM - fm) < WGM ? (nM - fm) : WGM;
        u.pm = fm + ((wgid % nig) % gsz); u.pn = (wgid % nig) / gsz; return true;
    }
    __device__ __forceinline__ void a_ready(const Unit&) const {}
    __device__ __forceinline__ void done(const Unit&) const {}
};
__device__ __forceinline__ unsigned cvt_pk_bf16(float lo, float hi) { unsigned r; asm volatile("v_cvt_pk_bf16_f32 %0, %1, %2" : "=v"(r) : "v"(lo), "v"(hi)); return r; }

template <class Epi, class Sched, bool STAMP = false>
__device__ __forceinline__ void gemm_phase(PG8_LAS unsigned char* lds, const Gemm g, const Sched& S, const Epi& E, unsigned long long* stamps) {
    int tid_o = threadIdx.x; asm volatile("" : "+v"(tid_o)); const int tid = tid_o, wid = __builtin_amdgcn_readfirstlane(tid >> 6), lane = tid & 63, wr = wid >> 2, wc = wid & 3, fr = lane & 15, fq = lane >> 4;
    const int K = g.K, nt = K / BK;
    int ts_lo = 0, ts_hi = 0, nts = 0; const unsigned long long rt_entry = STAMP ? (unsigned long long)wall_clock64() : 0ull;
#define PG8_STAMP() do { if (STAMP && wid == 0 && nts < 64) { const unsigned long long _c = (unsigned long long)clock64(); \
        ts_lo = (lane == nts) ? (int)(unsigned)_c : ts_lo; ts_hi = (lane == nts) ? (int)(unsigned)(_c >> 32) : ts_hi; ++nts; } } while (0)
    PG8_STAMP();
    unsigned voffA[2], voffB[2];
#pragma unroll
    for (int i = 0; i < 2; ++i) { int R, C; stage_rc(tid * 16 + i * 8192, R, C); const int Rb = Epi::PERM ? ((R & ~31) + perm32(R & 31)) : R;
        voffA[i] = (unsigned)(R * K + C) * 2u; voffB[i] = (unsigned)(Rb * K + C) * 2u; }
    const size_t kstep = (size_t)(BK * 2);
    const size_t hstep = (size_t)HALF * K * 2;
    const size_t tstep = 2 * hstep;
    const unsigned ldsw = (unsigned)wid * 1024u;
    const int aoff = lds_byte(wr * 64 + fr, fq * 8), boff = lds_byte(wc * 32 + fr, fq * 8);
#define PG8_SA(b, h) (((b) * 2 + (h)) * HTB)
#define PG8_SB(b, h) ((4 + (b) * 2 + (h)) * HTB)
#define PG8_STAGE(bufoff, gbase, voff) do { _Pragma("unroll") for (int _i = 0; _i < 2; ++_i) \
        __builtin_amdgcn_global_load_lds((const unsigned*)((const char*)(gbase) + (voff)[_i]), (PG8_LAS unsigned*)(lds + (bufoff) + ldsw + _i * 8192), 16, 0, 0); } while (0)
#define PG8_LDA(dst, b, h) do { _Pragma("unroll") for (int m = 0; m < 4; ++m) _Pragma("unroll") for (int k = 0; k < 2; ++k) dst[m][k] = *(const PG8_LAS bf16x8*)(lds + PG8_SA(b, h) + aoff + m * 2048 + k * 1024); } while (0)
#define PG8_LDB(dst, b, h) do { _Pragma("unroll") for (int n = 0; n < 2; ++n) _Pragma("unroll") for (int k = 0; k < 2; ++k) dst[n][k] = *(const PG8_LAS bf16x8*)(lds + PG8_SB(b, h) + boff + n * 2048 + k * 1024); } while (0)
#define PG8_MMA(ai, bj, At, Bt) do { __builtin_amdgcn_s_setprio(1); _Pragma("unroll") for (int m = 0; m < 4; ++m) _Pragma("unroll") for (int n = 0; n < 2; ++n) _Pragma("unroll") for (int k = 0; k < 2; ++k) \
        acc[ai][bj][m][n] = __builtin_amdgcn_mfma_f32_16x16x32_bf16(Bt[n][k], At[m][k], acc[ai][bj][m][n], 0, 0, 0); __builtin_amdgcn_s_setprio(0); } while (0)
#define PG8_WAIT_V(n) asm volatile("s_waitcnt vmcnt(" #n ")" ::: "memory")
#define PG8_WAIT_L(n) asm volatile("s_waitcnt lgkmcnt(" #n ")" ::: "memory")
#define PG8_BAR __builtin_amdgcn_s_barrier()
#define PG8_SCHED __builtin_amdgcn_sched_barrier(0)
    Unit cur, nxt; int ui = 0;
    if (!S.next(0, cur)) return;
    f32x4 acc[2][2][4][2];
#pragma unroll
    for (int a = 0; a < 2; ++a)
#pragma unroll
        for (int b = 0; b < 2; ++b)
#pragma unroll
            for (int m = 0; m < 4; ++m)
#pragma unroll
                for (int n = 0; n < 2; ++n) { if constexpr (Epi::HAS_INIT) acc[a][b][m][n] = E.init(cur, wr, wc, fr, fq, a, b, m, n); else acc[a][b][m][n] = (f32x4){0.f, 0.f, 0.f, 0.f}; }
    bf16x8 At[4][2], B0[2][2], B1[2][2];
    const char* cA = (const char*)g.A + (size_t)cur.pm * tstep; const char* cB = (const char*)g.Bt + (size_t)cur.pn * tstep;
    S.a_ready(cur);
    PG8_STAGE(PG8_SB(0, 0), cB, voffB); PG8_STAGE(PG8_SA(0, 0), cA, voffA); PG8_STAGE(PG8_SB(0, 1), cB + hstep, voffB); PG8_STAGE(PG8_SA(0, 1), cA + hstep, voffA);
    if (wr == 1) PG8_BAR;
    PG8_WAIT_V(4); PG8_BAR;
    PG8_STAGE(PG8_SB(1, 0), cB + kstep, voffB); PG8_STAGE(PG8_SA(1, 0), cA + kstep, voffA); PG8_STAGE(PG8_SB(1, 1), cB + hstep + kstep, voffB);
    PG8_WAIT_V(6); PG8_BAR;
    PG8_STAMP();
    for (;;) {
        const bool has_next = S.next(ui + 1, nxt);
        const char* nA = has_next ? (const char*)g.A + (size_t)nxt.pm * tstep : cA; const char* nB = has_next ? (const char*)g.Bt + (size_t)nxt.pn * tstep : cB;
        for (int t = 0; t < nt; t += 2) {
            const bool last = (t == nt - 2);
            const char* a1 = cA + (size_t)(t + 1) * kstep;
            const char* a2 = last ? nA : cA + (size_t)(t + 2) * kstep; const char* b2 = last ? nB : cB + (size_t)(t + 2) * kstep;
            const char* a3 = a2 + kstep; const char* b3 = b2 + kstep;
            if (last && has_next) S.a_ready(nxt);
            PG8_LDB(B0, 0, 0); PG8_SCHED; PG8_LDA(At, 0, 0); PG8_STAGE(PG8_SA(1, 1), a1 + hstep, voffA);
            PG8_WAIT_L(8); PG8_BAR; PG8_WAIT_L(0); PG8_MMA(0, 0, At, B0); PG8_BAR; PG8_SCHED;
            PG8_LDB(B1, 0, 1); PG8_STAGE(PG8_SB(0, 0), b2, voffB);
            PG8_BAR; PG8_WAIT_L(0); PG8_MMA(0, 1, At, B1); PG8_BAR;
            PG8_LDA(At, 0, 1); PG8_STAGE(PG8_SA(0, 0), a2, voffA);
            PG8_BAR; PG8_WAIT_L(0); PG8_MMA(1, 0, At, B0); PG8_BAR; PG8_SCHED;
            PG8_STAGE(PG8_SB(0, 1), b2 + hstep, voffB);
            PG8_WAIT_V(6); PG8_BAR; PG8_MMA(1, 1, At, B1); PG8_BAR;
            PG8_LDB(B0, 1, 0); PG8_SCHED; PG8_LDA(At, 1, 0); PG8_STAGE(PG8_SA(0, 1), a2 + hstep, voffA);
            PG8_WAIT_L(8); PG8_BAR; PG8_WAIT_L(0); PG8_MMA(0, 0, At, B0); PG8_BAR; PG8_SCHED;
            PG8_LDB(B1, 1, 1); PG8_STAGE(PG8_SB(1, 0), b3, voffB);
            PG8_BAR; PG8_WAIT_L(0); PG8_MMA(0, 1, At, B1); PG8_BAR;
            PG8_LDA(At, 1, 1); PG8_STAGE(PG8_SA(1, 0), a3, voffA);
            PG8_BAR; PG8_WAIT_L(0); PG8_MMA(1, 0, At, B0); PG8_BAR; PG8_SCHED;
            PG8_STAGE(PG8_SB(1, 1), b3 + hstep, voffB);
            PG8_WAIT_V(6); PG8_BAR; PG8_MMA(1, 1, At, B1); PG8_BAR;
        }
        PG8_STAMP();
        if constexpr (!Epi::AFTER_DRAIN) { E(acc, cur, wr, wc, fr, fq); S.done(cur); }
        PG8_STAMP();
        if (!has_next) break;
#pragma unroll
        for (int a = 0; a < 2; ++a)
#pragma unroll
            for (int b = 0; b < 2; ++b)
#pragma unroll
                for (int m = 0; m < 4; ++m)
#pragma unroll
                    for (int n = 0; n < 2; ++n) { if constexpr (Epi::HAS_INIT) acc[a][b][m][n] = E.init(nxt, wr, wc, fr, fq, a, b, m, n); else acc[a][b][m][n] = (f32x4){0.f, 0.f, 0.f, 0.f}; }
        cur = nxt; cA = nA; cB = nB; ++ui;
    }
    PG8_WAIT_V(0);
    if (wr == 0) PG8_BAR;
    PG8_BAR;
    if constexpr (Epi::AFTER_DRAIN) { E.fused(acc, cur, wr, wc, fr, fq, lds, wid, lane); S.done(cur); }
    PG8_STAMP();
    if (STAMP && wid == 0) { stamps[lane] = lane < nts ? (((unsigned long long)(unsigned)ts_hi << 32) | (unsigned)ts_lo) : 0ull;
        if (lane == 62) stamps[62] = rt_entry; if (lane == 63) stamps[63] = (unsigned long long)wall_clock64(); }
#undef PG8_STAMP
#undef PG8_SA
#undef PG8_SB
#undef PG8_STAGE
#undef PG8_LDA
#undef PG8_LDB
#undef PG8_MMA
#undef PG8_WAIT_V
#undef PG8_WAIT_L
#undef PG8_BAR
#undef PG8_SCHED
}
}
#define XB_TMO      128
#define XB_XCNT(j)  (256  + 64 * (j))
#define XB_XSUB(j)  (1280 + 64 * (j))
#define XB_XGEN(j)  (2304 + 64 * (j))
#define XB_TOP      3328
#define XB_TOPGEN   3392
#define XCD_BAR_WORDS 3456
#define XB_SPIN_CAP (1u << 18)
#define LAS __attribute__((address_space(3)))

__device__ __forceinline__ unsigned xb_ld(unsigned* p)              { return __hip_atomic_load(p, __ATOMIC_RELAXED, __HIP_MEMORY_SCOPE_AGENT); }
__device__ __forceinline__ unsigned xb_add(unsigned* p, unsigned v) { return __hip_atomic_fetch_add(p, v, __ATOMIC_RELAXED, __HIP_MEMORY_SCOPE_AGENT); }
__device__ __forceinline__ unsigned xb_xcc_id() { return (unsigned)__builtin_amdgcn_s_getreg((3 << 11) | 20) & 0xFu; }
#define XB_SPIN(cond, bar) do { unsigned _sp = 0; while (cond) { __builtin_amdgcn_s_sleep(1); \
    if ((++_sp & 255u) == 0u) { if (xb_ld(&(bar)[XB_TMO])) break; if (_sp > XB_SPIN_CAP) { atomicAdd(&(bar)[XB_TMO], 1u); break; } } } } while (0)

struct XcdBarrier {
    unsigned* bar; unsigned x;
    volatile LAS unsigned* st;
};

__device__ __forceinline__ XcdBarrier xcd_barrier_post(unsigned* bar, volatile LAS unsigned* st) {
    XcdBarrier b; b.bar = bar; b.x = xb_xcc_id(); b.st = st;
    if (threadIdx.x == 0) (void)xb_add(&bar[XB_XCNT(b.x)], 1u);
    return b;
}
__device__ __forceinline__ void xcd_barrier_complete(unsigned* bar, unsigned x, unsigned& nloc, unsigned& nx) {
    const unsigned G = gridDim.x * gridDim.y * gridDim.z;
    unsigned sum, cnt, mine, sp = 0u;
    for (;;) {
        sum = 0u; cnt = 0u; mine = 0u;
#pragma unroll
        for (unsigned j = 0; j < 16; ++j) { const unsigned c = xb_ld(&bar[XB_XCNT(j)]); sum += c; cnt += (c > 0u) ? 1u : 0u; mine = (j == x) ? c : mine; }
        if (sum == G) break;
        __builtin_amdgcn_s_sleep(1);
        if ((++sp & 255u) == 0u) { if (xb_ld(&bar[XB_TMO])) break; if (sp > XB_SPIN_CAP) { atomicAdd(&bar[XB_TMO], 1u); break; } }
    }
    nloc = mine > 0u ? mine : 1u; nx = cnt > 0u ? cnt : 1u;
}

__device__ __forceinline__ void xcd_barrier(const XcdBarrier& b) {
    asm volatile("s_waitcnt vmcnt(0)" ::: "memory");
    __syncthreads();
    if (threadIdx.x == 0) {
        unsigned* bar = b.bar;
        __builtin_amdgcn_s_waitcnt(0);
        unsigned nloc = b.st[0], nx = b.st[1];
        if (nloc == 0u) { xcd_barrier_complete(bar, b.x, nloc, nx); b.st[0] = nloc; b.st[1] = nx; }
        const unsigned old = xb_add(&bar[XB_XSUB(b.x)], 1u);
        const unsigned gen = old / nloc;
        if (old + 1u == (gen + 1u) * nloc) {
            __builtin_amdgcn_fence(__ATOMIC_RELEASE, "agent");
            asm volatile("s_waitcnt vmcnt(0)" ::: "memory");
            const unsigned og = xb_add(&bar[XB_TOP], 1u);
            const unsigned tg = og / nx;
            if (og + 1u == (tg + 1u) * nx) xb_add(&bar[XB_TOPGEN], 1u);
            else XB_SPIN(xb_ld(&bar[XB_TOPGEN]) == tg, bar);
            __builtin_amdgcn_fence(__ATOMIC_ACQUIRE, "agent");
            xb_add(&bar[XB_XGEN(b.x)], 1u);
            asm volatile("s_waitcnt vmcnt(0)" ::: "memory");
        } else {
            XB_SPIN(xb_ld(&bar[XB_XGEN(b.x)]) == gen, bar);
            __builtin_amdgcn_fence(__ATOMIC_ACQUIRE, "agent");
            asm volatile("s_waitcnt vmcnt(0)" ::: "memory");
        }
    }
    __syncthreads();
}

namespace cg = cooperative_groups;
__device__ __forceinline__ int otid() { int t = threadIdx.x; asm volatile("" : "+v"(t)); return t; }
__device__ __forceinline__ int obid() { int b = blockIdx.x; asm volatile("" : "+s"(b)); return b; }
typedef unsigned short u16;
using pg8::bf16x8; using pg8::f32x4;
typedef unsigned u32x4v __attribute__((ext_vector_type(4)));
typedef unsigned u32x2v __attribute__((ext_vector_type(2)));
typedef float f32x4v __attribute__((ext_vector_type(4)));

constexpr int NTOK = 65536, DM = 1024, DFF = 2816;
constexpr int EVC = 3840, ODC = 4608;
constexpr float ALPHA_F = 1.681792830507429f;
constexpr int HALF_ROWS = 32768, Q_ROWS = 16384;

constexpr size_t SZ_FFN_IN = (size_t)5632 * 1024 * 2, SZ_FFN_OUT = (size_t)1024 * 2816 * 2;
constexpr size_t SZ_EV_IN = (size_t)EVC * 1024 * 2, SZ_OD_IN = (size_t)ODC * 1024 * 2, SZ_SQ = (size_t)1024 * 1024 * 2;
constexpr size_t WS_FFN_IN = 0;
constexpr size_t WS_FFN_OUT = WS_FFN_IN + 8 * SZ_FFN_IN;
constexpr size_t WS_EV_IN = WS_FFN_OUT + 8 * SZ_FFN_OUT;
constexpr size_t WS_OD_IN = WS_EV_IN + 2 * SZ_EV_IN;
constexpr size_t WS_EV_OUT = WS_OD_IN + 2 * SZ_OD_IN;
constexpr size_t WS_OD_OUT = WS_EV_OUT + 2 * SZ_SQ;
constexpr size_t WS_XB = WS_OD_OUT + 2 * SZ_SQ;
constexpr size_t WS_ROPE = WS_XB + (size_t)NTOK * DM * 2;
constexpr size_t WS_OMLB = WS_ROPE + 4096;
constexpr size_t WS_SCR = WS_ROPE + 16384;
constexpr size_t SZ_Y = (size_t)Q_ROWS * ODC * 2;
constexpr size_t SZ_ST = (size_t)256 * 16 * 16384 * 2;
constexpr size_t SZ_DEC = (size_t)256 * 16 * 128 * 4;
constexpr size_t SZ_NV = (size_t)256 * 8 * 128 * 4;
constexpr size_t WS_Y = WS_SCR, WS_ST = WS_Y + SZ_Y, WS_DEC = WS_ST + SZ_ST, WS_NV = WS_DEC + SZ_DEC, WS_END = WS_NV + SZ_NV;
constexpr size_t WS_STATS = WS_END;
constexpr size_t WS_ACT = WS_SCR;

struct Params {
    const float* in[19];
    float* X;
    unsigned char* ws;
};

__device__ __forceinline__ float bf2f(u16 b) { return __uint_as_float(((unsigned)b) << 16); }
__device__ __forceinline__ u16 f2bf(float f) { unsigned u = __float_as_uint(f); u += 0x7FFFu + ((u >> 16) & 1u); return (u16)(u >> 16); }
typedef float f32x2c __attribute__((ext_vector_type(2)));
typedef __bf16 bf16x2c __attribute__((ext_vector_type(2)));
__device__ __forceinline__ unsigned pk2(float lo, float hi) { f32x2c v = {lo, hi}; bf16x2c r = __builtin_convertvector(v, bf16x2c); return __builtin_bit_cast(unsigned, r); }
__device__ __forceinline__ float sigmoidf_(float x) { return 1.0f / (1.0f + __expf(-x)); }
__device__ __forceinline__ float siluf_(float x) { return x / (1.0f + __expf(-x)); }
__device__ __forceinline__ float logsigf_(float x) { return fminf(x, 0.f) - log1pf(__expf(-fabsf(x))); }
__device__ __forceinline__ float expc(float x) { return __expf(fminf(x, 80.f)); }
__device__ __forceinline__ void load16(const u16* p, float* o) {
    const u32x4v a = *(const u32x4v*)p, b = *(const u32x4v*)(p + 8);
#pragma unroll
    for (int i = 0; i < 4; ++i) { o[2 * i] = __uint_as_float(a[i] << 16); o[2 * i + 1] = __uint_as_float(a[i] & 0xffff0000u);
                                  o[8 + 2 * i] = __uint_as_float(b[i] << 16); o[8 + 2 * i + 1] = __uint_as_float(b[i] & 0xffff0000u); }
}
__device__ __forceinline__ void store16(u16* p, const float* v) {
    u32x4v a, b;
#pragma unroll
    for (int i = 0; i < 4; ++i) { a[i] = pk2(v[2 * i], v[2 * i + 1]); b[i] = pk2(v[8 + 2 * i], v[8 + 2 * i + 1]); }
    *(u32x4v*)p = a; *(u32x4v*)(p + 8) = b;
}

struct EpiSwiGLU {
    static constexpr bool PERM = true, AFTER_DRAIN = false, HAS_INIT = false;
    u16* O; int ldc;
    __device__ __forceinline__ void operator()(const f32x4 (&acc)[2][2][4][2], const pg8::Unit& u, int wr, int wc, int fr, int fq) const {
        const int row0 = u.pm * 256 + wr * 64 + fr, col0 = u.pn * 128 + wc * 32 + 8 * fq;
#pragma unroll
        for (int ai = 0; ai < 2; ++ai)
#pragma unroll
            for (int m = 0; m < 4; ++m) {
                u16* dst = O + (size_t)(row0 + ai * 128 + m * 16) * ldc + col0;
                float v[8];
#pragma unroll
                for (int n = 0; n < 2; ++n)
#pragma unroll
                    for (int j = 0; j < 4; ++j) { const float g = acc[ai][0][m][n][j], uu = acc[ai][1][m][n][j]; v[4 * n + j] = siluf_(g) * uu; }
                u32x4v o; o[0] = pk2(v[0], v[1]); o[1] = pk2(v[2], v[3]); o[2] = pk2(v[4], v[5]); o[3] = pk2(v[6], v[7]);
                *(u32x4v*)dst = o;
            }
    }
};
struct EpiBf16 {
    static constexpr bool PERM = true, AFTER_DRAIN = false, HAS_INIT = false;
    u16* O; int ldc;
    __device__ __forceinline__ void operator()(const f32x4 (&acc)[2][2][4][2], const pg8::Unit& u, int wr, int wc, int fr, int fq) const {
        const int row0 = u.pm * 256 + wr * 64 + fr, col0 = u.pn * 256 + wc * 32 + 8 * fq;
#pragma unroll
        for (int ai = 0; ai < 2; ++ai)
#pragma unroll
            for (int m = 0; m < 4; ++m)
#pragma unroll
                for (int bj = 0; bj < 2; ++bj) {
                    u16* dst = O + (size_t)(row0 + ai * 128 + m * 16) * ldc + col0 + bj * 128;
                    const f32x4 a = acc[ai][bj][m][0], b = acc[ai][bj][m][1];
                    u32x4v o; o[0] = pk2(a[0], a[1]); o[1] = pk2(a[2], a[3]); o[2] = pk2(b[0], b[1]); o[3] = pk2(b[2], b[3]);
                    *(u32x4v*)dst = o;
                }
    }
};
struct EpiResid {
    static constexpr bool PERM = false, AFTER_DRAIN = false, HAS_INIT = true;
    float* X; const float* src; float scale; const float* stats; const float* g; const float* b; bool dry;
    __device__ __forceinline__ f32x4 init(const pg8::Unit& u, int wr, int wc, int fr, int fq, int ai, int bj, int m, int n) const {
        const size_t row = (size_t)(u.pm * 256 + wr * 64 + fr + ai * 128 + m * 16);
        const int col = u.pn * 256 + wc * 32 + 4 * fq + bj * 128 + n * 16;
        f32x4v old = *(const f32x4v*)(src + row * DM + col);
        if (stats) { const f32x2c st = *(const f32x2c*)(stats + 2 * row); const f32x4v gv = *(const f32x4v*)(g + col), bv = *(const f32x4v*)(b + col);
            old = (old - st[0]) * st[1] * gv + bv; }
        const float k = ALPHA_F / scale;
        f32x4 r; r[0] = old[0] * k; r[1] = old[1] * k; r[2] = old[2] * k; r[3] = old[3] * k;
        return r;
    }
    __device__ __forceinline__ void operator()(const f32x4 (&acc)[2][2][4][2], const pg8::Unit& u, int wr, int wc, int fr, int fq) const {
        if (dry) return;
        const int row0 = u.pm * 256 + wr * 64 + fr, col0 = u.pn * 256 + wc * 32 + 4 * fq;
#pragma unroll
        for (int ai = 0; ai < 2; ++ai)
#pragma unroll
            for (int m = 0; m < 4; ++m) {
                float* rowp = X + (size_t)(row0 + ai * 128 + m * 16) * DM + col0;
#pragma unroll
                for (int bj = 0; bj < 2; ++bj)
#pragma unroll
                    for (int n = 0; n < 2; ++n) {
                        const f32x4 a = acc[ai][bj][m][n];
                        f32x4v r; r[0] = scale * a[0]; r[1] = scale * a[1]; r[2] = scale * a[2]; r[3] = scale * a[3];
                        *(f32x4v*)(rowp + bj * 128 + n * 16) = r;
                    }
            }
    }
};

template <class Epi>
__device__ __forceinline__ void run_gemm(unsigned char* shm, const u16* A, const u16* Bt, int M, int N, int K, const Epi& E) {
    pg8::Gemm g; g.A = A; g.Bt = Bt; g.M = M; g.N = N; g.K = K;
    pg8::StaticOrder S; S.init(M, N, (int)gridDim.x, obid());
    pg8::gemm_phase<Epi, pg8::StaticOrder, false>((PG8_LAS unsigned char*)shm, g, S, E, nullptr);
    __syncthreads();
}

__device__ __forceinline__ void transpose_tile(unsigned char* shm, const float* src, int K, int Nsrc, u16* dst, int r0, int n0, int k0) {
    float* tile = (float*)shm;
    const int tid = otid();
    {
        const int r = tid >> 4, c4 = (tid & 15) * 4;
#pragma unroll
        for (int i = 0; i < 2; ++i) {
            const int k = r + 32 * i;
            f32x4v v = {0.f, 0.f, 0.f, 0.f};
            if (n0 + c4 < Nsrc) v = *(const f32x4v*)(src + (size_t)(k0 + k) * Nsrc + n0 + c4);
            tile[k * 65 + c4 + 0] = v[0]; tile[k * 65 + c4 + 1] = v[1]; tile[k * 65 + c4 + 2] = v[2]; tile[k * 65 + c4 + 3] = v[3];
        }
    }
    __syncthreads();
    {
        const int n = tid >> 3, kg = (tid & 7) * 8;
        float v[8];
#pragma unroll
        for (int j = 0; j < 8; ++j) v[j] = tile[(kg + j) * 65 + n];
        u32x4v o; o[0] = pk2(v[0], v[1]); o[1] = pk2(v[2], v[3]); o[2] = pk2(v[4], v[5]); o[3] = pk2(v[6], v[7]);
        *(u32x4v*)(dst + (size_t)(r0 + n) * K + k0 + kg) = o;
    }
    __syncthreads();
}

__device__ void phase_prep(const Params& p, unsigned char* shm) {
    const int tid = otid();
    u16* XB = (u16*)(p.ws + WS_XB);
    {
        const size_t n4 = (size_t)NTOK * DM / 4, half4 = n4 / 2;
        for (size_t i = (size_t)blockIdx.x * 512 + tid; i < n4; i += (size_t)gridDim.x * 512) {
            const f32x4v v = (i < half4) ? ((const f32x4v*)p.in[0])[i] : ((const f32x4v*)p.in[1])[i - half4];
            u32x2v o; o[0] = pk2(v[0], v[1]); o[1] = pk2(v[2], v[3]);
            ((u32x2v*)XB)[i] = o;
        }
    }
    if (blockIdx.x == 0 && tid < 64) {
        double* rope = (double*)(p.ws + WS_ROPE);
        rope[tid] = exp2(-(double)tid / 64.0 * 13.287712379549449) / 6.283185307179586;
    }
    if (blockIdx.x == 1) {
        float* om = (float*)(p.ws + WS_OMLB);
        for (int i = tid; i < 2048; i += 512) {
            const int jj = i >> 10, rest = i & 1023;
            float lb = 0.f;
            if (jj > 0) lb = sigmoidf_(p.in[16][1024 + rest] - p.in[16][rest]);
            om[i] = 1.0f - lb;
        }
    }
    const int T_FI = 88 * 16, T_FO = 16 * 44, T_EI = 60 * 16, T_OI = 72 * 16, T_SQ = 16 * 16;
    const int total = 8 * T_FI + 8 * T_FO + 2 * T_EI + 2 * T_OI + 4 * T_SQ;
    for (int u = blockIdx.x; u < total; u += gridDim.x) {
        int r = u;
        if (r < 8 * T_FI) {
            const int mi = r / T_FI, ti = r % T_FI, which = mi >> 2, l = mi & 3;
            const float* src = p.in[which ? 4 : 2] + (size_t)l * 1024 * 5632;
            u16* dst = (u16*)(p.ws + WS_FFN_IN + (size_t)mi * SZ_FFN_IN);
            const int rt = ti >> 4, kt = ti & 15;
            const int r0 = rt * 64, pn = r0 >> 8, hh = (r0 >> 7) & 1, jj = (r0 >> 6) & 1;
            transpose_tile(shm, src, 1024, 5632, dst, r0, hh * 2816 + pn * 128 + jj * 64, kt * 64);
            continue;
        }
        r -= 8 * T_FI;
        if (r < 8 * T_FO) {
            const int mi = r / T_FO, ti = r % T_FO, which = mi >> 2, l = mi & 3;
            const float* src = p.in[which ? 5 : 3] + (size_t)l * 2816 * 1024;
            u16* dst = (u16*)(p.ws + WS_FFN_OUT + (size_t)mi * SZ_FFN_OUT);
            const int rt = ti / 44, kt = ti % 44;
            transpose_tile(shm, src, 2816, 1024, dst, rt * 64, rt * 64, kt * 64);
            continue;
        }
        r -= 8 * T_FO;
        if (r < 2 * T_EI) {
            const int j = r / T_EI, ti = r % T_EI;
            const float* src = p.in[8] + (size_t)j * 1024 * 3632;
            u16* dst = (u16*)(p.ws + WS_EV_IN + (size_t)j * SZ_EV_IN);
            const int rt = ti >> 4, kt = ti & 15;
            transpose_tile(shm, src, 1024, 3632, dst, rt * 64, rt * 64, kt * 64);
            continue;
        }
        r -= 2 * T_EI;
        if (r < 2 * T_OI) {
            const int j = r / T_OI, ti = r % T_OI;
            const float* src = p.in[15] + (size_t)j * 1024 * 4608;
            u16* dst = (u16*)(p.ws + WS_OD_IN + (size_t)j * SZ_OD_IN);
            const int rt = ti >> 4, kt = ti & 15;
            transpose_tile(shm, src, 1024, 4608, dst, rt * 64, rt * 64, kt * 64);
            continue;
        }
        r -= 2 * T_OI;
        {
            const int mi = r / T_SQ, ti = r % T_SQ;
            const float* src = p.in[mi < 2 ? 14 : 18] + (size_t)(mi & 1) * 1024 * 1024;
            u16* dst = (u16*)(p.ws + (mi < 2 ? WS_EV_OUT : WS_OD_OUT) + (size_t)(mi & 1) * SZ_SQ);
            const int rt = ti >> 4, kt = ti & 15;
            transpose_tile(shm, src, 1024, 1024, dst, rt * 64, rt * 64, kt * 64);
        }
    }
}

__device__ void phase_ln(const Params& p, const float* g, const float* b, bool write_x) {
    const int tid = otid(); const int lane = tid & 63, w = tid >> 6;
    u16* XB = (u16*)(p.ws + WS_XB); float* STATS = (float*)(p.ws + WS_STATS);
    f32x4v gv[4], bv[4];
#pragma unroll
    for (int i = 0; i < 4; ++i) { gv[i] = *(const f32x4v*)(g + 4 * lane + 256 * i); bv[i] = *(const f32x4v*)(b + 4 * lane + 256 * i); }
    for (int row = blockIdx.x * 8 + w; row < NTOK; row += gridDim.x * 8) {
        float* xr = p.X + (size_t)row * DM;
        f32x4v v[4];
#pragma unroll
        for (int i = 0; i < 4; ++i) v[i] = *(const f32x4v*)(xr + 4 * lane + 256 * i);
        float s = 0.f;
#pragma unroll
        for (int i = 0; i < 4; ++i) s += v[i][0] + v[i][1] + v[i][2] + v[i][3];
#pragma unroll
        for (int o = 32; o >= 1; o >>= 1) s += __shfl_xor(s, o);
        const float mu = s * (1.0f / 1024.0f);
        float q = 0.f;
#pragma unroll
        for (int i = 0; i < 4; ++i)
#pragma unroll
            for (int j = 0; j < 4; ++j) { const float d = v[i][j] - mu; q += d * d; }
#pragma unroll
        for (int o = 32; o >= 1; o >>= 1) q += __shfl_xor(q, o);
        const float rs = rsqrtf(q * (1.0f / 1024.0f) + 1e-5f);
        if (lane == 0) { f32x2c st; st[0] = mu; st[1] = rs; *(f32x2c*)(STATS + 2 * (size_t)row) = st; }
#pragma unroll
        for (int i = 0; i < 4; ++i) {
            f32x4v o4;
#pragma unroll
            for (int j = 0; j < 4; ++j) o4[j] = (v[i][j] - mu) * rs * gv[i][j] + bv[i][j];
            if (write_x) *(f32x4v*)(xr + 4 * lane + 256 * i) = o4;
            u32x2v o2; o2[0] = pk2(o4[0], o4[1]); o2[1] = pk2(o4[2], o4[3]);
            *(u32x2v*)(XB + (size_t)row * DM + 4 * lane + 256 * i) = o2;
        }
    }
}

constexpr int QS = 136, VTS = 72, BS = 132, PS = 72;
constexpr int OFF_QN = 0;
constexpr int OFF_KN = OFF_QN + 64 * QS * 2;
constexpr int OFF_VT = OFF_KN + 64 * QS * 2;
constexpr int OFF_B = OFF_VT + 128 * VTS * 2;
constexpr int OFF_QS = OFF_B + 64 * BS * 4;
constexpr int OFF_KS = OFF_QS + 64 * QS * 2;
constexpr int OFF_QI = OFF_KS + 64 * QS * 2;
constexpr int OFF_P = OFF_QI + 64 * QS * 2;
constexpr int OFF_MISC = OFF_P + 64 * PS * 2;
constexpr int SCAN_LDS = OFF_MISC + 9216;
static_assert(SCAN_LDS <= 160 * 1024, "lds");
static_assert((OFF_B % 16) == 0 && (OFF_QS % 16) == 0 && (OFF_P % 16) == 0 && (OFF_MISC % 16) == 0, "align");

struct ScanCtx {
    const u16* Y; int ld;
    u16* H;
    u16* ST; float* DEC; float* NV;
    int cps;
    int even;
    int j;
    const float *gate_b, *conv_w, *a2_w, *a2_b, *norm_w, *lb_logits;
    const double* rope; const float* omlb;
};

__device__ __forceinline__ void unpack16(const u32x4v a, const u32x4v b, float* o) {
#pragma unroll
    for (int i = 0; i < 4; ++i) { o[2 * i] = __uint_as_float(a[i] << 16); o[2 * i + 1] = __uint_as_float(a[i] & 0xffff0000u);
                                  o[8 + 2 * i] = __uint_as_float(b[i] << 16); o[8 + 2 * i + 1] = __uint_as_float(b[i] & 0xffff0000u); }
}
__device__ __forceinline__ void put_v(u16* Vn, int t, int d0, const u32x4v a, const u32x4v b) {
    *(u32x4v*)(Vn + t * QS + d0) = a; *(u32x4v*)(Vn + t * QS + d0 + 8) = b;
}
template <int MODE, int MIX>
__device__ void scan_unit(const ScanCtx& cx, int c, int h, unsigned char* lds) {
    constexpr int dk = (MIX == 1) ? 64 : 128;
    constexpr bool scalar = (MIX == 0 || MIX == 3);
    constexpr int NKK = dk / 32;
    const int head = (MIX & 1) * 4 + h;
    const int tid = otid(), lane = tid & 63, w = tid >> 6;
    u16* Qn = (u16*)(lds + OFF_QN); u16* Kn = (u16*)(lds + OFF_KN); u16* VT = (u16*)(lds + OFF_VT); u16* Vg = (u16*)(lds + OFF_QI);
    float* Bm = (float*)(lds + OFF_B);
    u16* Qs = (u16*)(lds + OFF_QS); u16* Ks = (u16*)(lds + OFF_KS); u16* Qi = (u16*)(lds + OFF_QI); u16* Pm = (u16*)(lds + OFF_P);
    u16* Pb = Qs;
    float* GT = (float*)(lds + OFF_MISC);
    float* NPREV = GT + 256;
    float* DEN = NPREV + 256;
    float* SEG = DEN + 128;
    float* BFB = SEG + 512;
    const int t = tid >> 3, g = tid & 7, d0 = g * 16;
    const int cs = c % cx.cps;
    const size_t row0 = (size_t)c * 64;
    const int ld = cx.ld;
    const u16* Yr = cx.Y + (row0 + t) * ld;
    const int lr = lane & 15, lq = lane >> 4;
    const float lgam = log1pf(-exp2f(-5.0f - (float)h));

    u32x4v rk[5][2], rq[5][2], rv[2], rg[2], rz[2][2], rba[4];
    float gr[4] = {0.f, 0.f, 0.f, 0.f}, nvp[2] = {0.f, 0.f};
    bf16x8 sb[2][NKK];
    if constexpr (MIX == 0) {
#pragma unroll
        for (int jt = 0; jt < 5; ++jt) {
            const int tt = cs * 64 + t + jt - 2;
            const bool ok = (tt >= 0 && tt < cx.cps * 64);
            const u16* src = cx.Y + (row0 + t + (ok ? jt - 2 : 0)) * ld + h * 128 + d0;
            rk[jt][0] = *(const u32x4v*)(src + 512); rk[jt][1] = *(const u32x4v*)(src + 512 + 8);
            if (!ok) { rk[jt][0] = (u32x4v){0u, 0u, 0u, 0u}; rk[jt][1] = (u32x4v){0u, 0u, 0u, 0u}; }
        }
        rv[0] = *(const u32x4v*)(Yr + 1024 + h * 128 + d0); rv[1] = *(const u32x4v*)(Yr + 1024 + h * 128 + d0 + 8);
        if (tid < 64) { const u16* yr = cx.Y + (row0 + tid) * ld + 2048;
#pragma unroll
            for (int i = 0; i < 4; ++i) gr[i] = bf2f(yr[4 * i + h]); }
        if (MODE == 1) { rg[0] = *(const u32x4v*)(Yr + 1536 + h * 128 + d0); rg[1] = *(const u32x4v*)(Yr + 1536 + h * 128 + d0 + 8);
            if (tid < 128) { nvp[0] = cx.NV[((size_t)c * 8 + h * 2 + 0) * 128 + tid]; nvp[1] = cx.NV[((size_t)c * 8 + h * 2 + 1) * 128 + tid]; } }
    } else if constexpr (MIX == 1) {
        if (g < 4) { if (MODE == 1) { rq[0][0] = *(const u32x4v*)(Yr + 2064 + h * 64 + d0); rq[0][1] = *(const u32x4v*)(Yr + 2064 + h * 64 + d0 + 8); } }
        else { rk[0][0] = *(const u32x4v*)(Yr + 2320 + h * 64 + d0 - 64); rk[0][1] = *(const u32x4v*)(Yr + 2320 + h * 64 + d0 - 64 + 8); }
        rv[0] = *(const u32x4v*)(Yr + 2576 + h * 128 + d0); rv[1] = *(const u32x4v*)(Yr + 2576 + h * 128 + d0 + 8);
#pragma unroll
        for (int i = 0; i < 4; ++i) rba[i] = *(const u32x4v*)(Yr + 3600 + 8 * i);
        if (MODE == 1) { rg[0] = *(const u32x4v*)(Yr + 3088 + h * 128 + d0); rg[1] = *(const u32x4v*)(Yr + 3088 + h * 128 + d0 + 8); }
    } else if constexpr (MIX == 2) {
        if (MODE == 1) { rq[0][0] = *(const u32x4v*)(Yr + h * 128 + d0); rq[0][1] = *(const u32x4v*)(Yr + h * 128 + d0 + 8); }
        rv[0] = *(const u32x4v*)(Yr + 1536 + h * 128 + d0); rv[1] = *(const u32x4v*)(Yr + 1536 + h * 128 + d0 + 8);
#pragma unroll
        for (int dd = 0; dd < 2; ++dd) { rz[dd][0] = *(const u32x4v*)(Yr + 512 + dd * 512 + h * 128 + d0); rz[dd][1] = *(const u32x4v*)(Yr + 512 + dd * 512 + h * 128 + d0 + 8); }
        if (MODE == 1) { rg[0] = *(const u32x4v*)(Yr + 2048 + h * 128 + d0); rg[1] = *(const u32x4v*)(Yr + 2048 + h * 128 + d0 + 8); }
    } else {
        const int gg = g & 3, isk = g >> 2;
        if (MODE == 1 || isk) { const u16* src = Yr + (isk ? 3072 : 2560) + h * 128 + gg * 16;
            rq[0][0] = *(const u32x4v*)src; rq[0][1] = *(const u32x4v*)(src + 8); rq[1][0] = *(const u32x4v*)(src + 64); rq[1][1] = *(const u32x4v*)(src + 72); }
        rv[0] = *(const u32x4v*)(Yr + 3584 + h * 128 + d0); rv[1] = *(const u32x4v*)(Yr + 3584 + h * 128 + d0 + 8);
        if (MODE == 1) { rg[0] = *(const u32x4v*)(Yr + 4096 + h * 128 + d0); rg[1] = *(const u32x4v*)(Yr + 4096 + h * 128 + d0 + 8); }
    }
    if (MODE == 1) {
#pragma unroll
        for (int dd = 0; dd < 2; ++dd)
#pragma unroll
            for (int kk = 0; kk < NKK; ++kk) sb[dd][kk] = *(const bf16x8*)(cx.ST + ((size_t)c * 16 + head * 2 + dd) * 16384 + (16 * w + lr) * 128 + 32 * kk + 8 * lq);
    }

    if constexpr (MIX == 0) {
#pragma unroll 1
        for (int which = 1; which >= (MODE == 0 ? 1 : 0); --which) {
            const int ch0 = which * 512 + h * 128 + d0;
            if (which == 0) {
#pragma unroll
                for (int jt = 0; jt < 5; ++jt) {
                    const int tt = cs * 64 + t + jt - 2;
                    const bool ok = (tt >= 0 && tt < cx.cps * 64);
                    const u16* src = cx.Y + (row0 + t + (ok ? jt - 2 : 0)) * ld + h * 128 + d0;
                    rk[jt][0] = *(const u32x4v*)src; rk[jt][1] = *(const u32x4v*)(src + 8);
                    if (!ok) { rk[jt][0] = (u32x4v){0u, 0u, 0u, 0u}; rk[jt][1] = (u32x4v){0u, 0u, 0u, 0u}; }
                }
            }
            float acc[16];
#pragma unroll
            for (int i = 0; i < 16; ++i) acc[i] = 0.f;
#pragma unroll
            for (int jt = 0; jt < 5; ++jt) {
                float xv[16];
                unpack16(rk[jt][0], rk[jt][1], xv);
                const f32x4v* wj = (const f32x4v*)(cx.conv_w + jt * 1024 + ch0);
#pragma unroll
                for (int q4 = 0; q4 < 4; ++q4) { const f32x4v wv = wj[q4];
#pragma unroll
                    for (int jx = 0; jx < 4; ++jx) acc[4 * q4 + jx] += xv[4 * q4 + jx] * wv[jx]; }
            }
            const float sc = which ? 0.08838834764831845f : 1.0f;
#pragma unroll
            for (int i = 0; i < 16; ++i) acc[i] = acc[i] * sc * __builtin_amdgcn_rcpf(1.0f + __expf(-acc[i]));
            store16((which ? Kn : Qn) + t * QS + d0, acc);
        }
        put_v(Vg, t, d0, rv[0], rv[1]);
        if (tid < 64) {
            GT[0 * 64 + tid] = gr[0] + cx.gate_b[0 + h]; GT[1 * 64 + tid] = logsigf_(gr[1] + cx.gate_b[4 + h]);
            GT[2 * 64 + tid] = gr[2] + cx.gate_b[8 + h]; GT[3 * 64 + tid] = logsigf_(gr[3] + cx.gate_b[12 + h]);
        }
        if (MODE == 1 && tid < 128) { NPREV[tid] = nvp[0]; NPREV[128 + tid] = nvp[1]; }
    } else if constexpr (MIX == 1) {
        if (g < 4) {
            if (MODE == 1) { float xv[16]; unpack16(rq[0][0], rq[0][1], xv);
#pragma unroll
                for (int i = 0; i < 16; ++i) xv[i] *= 0.125f;
                store16(Qn + t * QS + d0, xv); }
        } else { *(u32x4v*)(Kn + t * QS + (d0 - 64)) = rk[0][0]; *(u32x4v*)(Kn + t * QS + (d0 - 64) + 8) = rk[0][1]; }
        put_v(Vg, t, d0, rv[0], rv[1]);
    } else if constexpr (MIX == 2) {
        if (MODE == 1) { float xv[16]; unpack16(rq[0][0], rq[0][1], xv);
#pragma unroll
            for (int i = 0; i < 16; ++i) xv[i] = xv[i] * 0.08838834764831845f * __builtin_amdgcn_rcpf(1.0f + __expf(-xv[i]));
            store16(Qn + t * QS + d0, xv); }
        put_v(Vg, t, d0, rv[0], rv[1]);
    } else {
        const int gg = g & 3, isk = g >> 2;
        if (MODE == 1 || isk) {
            float x1[16], x2[16], o1[16], o2[16];
            unpack16(rq[0][0], rq[0][1], x1); unpack16(rq[1][0], rq[1][1], x2);
            const double pos = (double)(cs * 64 + t);
            const float sc = isk ? 0.08838834764831845f : 1.0f;
#pragma unroll
            for (int i = 0; i < 16; ++i) {
                const double tr = pos * cx.rope[gg * 16 + i];
                const float fr = (float)(tr - rint(tr));
                const float sn = __builtin_amdgcn_sinf(fr) * sc, cn = __builtin_amdgcn_cosf(fr) * sc;
                o1[i] = x1[i] * cn - x2[i] * sn; o2[i] = x1[i] * sn + x2[i] * cn;
            }
            u16* dstp = (isk ? Kn : Qn) + t * QS;
            store16(dstp + gg * 16, o1); store16(dstp + 64 + gg * 16, o2);
        }
        put_v(Vg, t, d0, rv[0], rv[1]);
    }
    __syncthreads();
    {
        const u32x4v a = *(const u32x4v*)(Vg + lane * QS + 16 * w), b = *(const u32x4v*)(Vg + lane * QS + 16 * w + 8);
#pragma unroll
        for (int i = 0; i < 4; ++i) {
            VT[(16 * w + 2 * i) * VTS + lane] = (u16)(a[i] & 0xffffu); VT[(16 * w + 2 * i + 1) * VTS + lane] = (u16)(a[i] >> 16);
            VT[(16 * w + 8 + 2 * i) * VTS + lane] = (u16)(b[i] & 0xffffu); VT[(16 * w + 8 + 2 * i + 1) * VTS + lane] = (u16)(b[i] >> 16);
        }
    }

    f32x4 acc_tot[4];
#pragma unroll
    for (int i = 0; i < 4; ++i) acc_tot[i] = (f32x4){0.f, 0.f, 0.f, 0.f};

    if constexpr (scalar && MODE == 1) {
        if constexpr (MIX == 0) {
            if (w < 2) {
                float v = GT[(1 + 2 * w) * 64 + lane];
                if (w == 0) {
#pragma unroll
                    for (int o = 1; o < 64; o <<= 1) { const float n = __shfl_up(v, o); if (lane >= o) v += n; }
                } else {
#pragma unroll
                    for (int o = 1; o < 64; o <<= 1) { const float n = __shfl_down(v, o); if (lane + o < 64) v += n; }
                }
                BFB[w * 64 + lane] = v;
            }
        } else {
            if (tid < 128) { const int dd = tid >> 6, tt = tid & 63; BFB[tid] = lgam * (float)(dd ? (64 - tt) : (tt + 1)); }
        }
        __syncthreads();
        {
            const int ti = w >> 1, tj0 = 2 * (w & 1);
            f32x4 sc[2] = {(f32x4){0.f, 0.f, 0.f, 0.f}, (f32x4){0.f, 0.f, 0.f, 0.f}};
#pragma unroll
            for (int kk = 0; kk < NKK; ++kk) {
                const bf16x8 af = *(const bf16x8*)(Qn + (16 * ti + lr) * QS + 32 * kk + 8 * lq);
#pragma unroll
                for (int jj = 0; jj < 2; ++jj) {
                    const bf16x8 bfr = *(const bf16x8*)(Kn + (16 * (tj0 + jj) + lr) * QS + 32 * kk + 8 * lq);
                    sc[jj] = __builtin_amdgcn_mfma_f32_16x16x32_bf16(af, bfr, sc[jj], 0, 0, 0);
                }
            }
#pragma unroll
            for (int dd = 0; dd < 2; ++dd) {
                u16* Pd = dd ? Pb : Pm;
#pragma unroll
                for (int jj = 0; jj < 2; ++jj) {
                    const int ss = 16 * (tj0 + jj) + lr;
                    const float bs = BFB[dd * 64 + ss] - ((MIX == 0) ? GT[(2 * dd) * 64 + ss] : 0.f);
#pragma unroll
                    for (int r = 0; r < 4; ++r) {
                        const int tt = 16 * ti + 4 * lq + r;
                        const bool keep = dd ? (ss >= tt) : (ss <= tt);
                        const float wgt = __expf(fminf(BFB[dd * 64 + tt] - bs, 60.f));
                        Pd[tt * PS + ss] = (u16)(pk2(keep ? sc[jj][r] * wgt : 0.f, 0.f) & 0xffffu);
                    }
                }
            }
        }
        __syncthreads();
        if constexpr (MIX == 0) {
            float pf[16], pbv[16], qv[16];
            const u32x4v p0 = *(const u32x4v*)(Pm + t * PS + 8 * g), p1 = *(const u32x4v*)(Pb + t * PS + 8 * g);
            unpack16(p0, p0, pf); unpack16(p1, p1, pbv);
            unpack16(*(const u32x4v*)(Qn + t * QS + d0), *(const u32x4v*)(Qn + t * QS + d0 + 8), qv);
            float vf = 0.f, vb2 = 0.f, qf = 0.f, qb = 0.f;
#pragma unroll
            for (int i = 0; i < 8; ++i) { vf += pf[i]; vb2 += pbv[i]; }
#pragma unroll
            for (int i = 0; i < 16; ++i) { qf += qv[i] * NPREV[d0 + i]; qb += qv[i] * NPREV[128 + d0 + i]; }
            vf += __expf(BFB[t]) * qf; vb2 += __expf(BFB[64 + t]) * qb;
            vf += __shfl_xor(vf, 1); vb2 += __shfl_xor(vb2, 1); vf += __shfl_xor(vf, 2); vb2 += __shfl_xor(vb2, 2); vf += __shfl_xor(vf, 4); vb2 += __shfl_xor(vb2, 4);
            if (g == 0) { DEN[t] = vf; DEN[64 + t] = vb2; }
            __syncthreads();
        }
#pragma unroll
        for (int dd = 0; dd < 2; ++dd) {
            const u16* Pd = dd ? Pb : Pm;
            f32x4 ad[4], ai[4];
#pragma unroll
            for (int i = 0; i < 4; ++i) { ad[i] = (f32x4){0.f, 0.f, 0.f, 0.f}; ai[i] = (f32x4){0.f, 0.f, 0.f, 0.f}; }
#pragma unroll
            for (int kk = 0; kk < 2; ++kk) {
                const bf16x8 vb = *(const bf16x8*)(VT + (16 * w + lr) * VTS + 32 * kk + 8 * lq);
#pragma unroll
                for (int ti = 0; ti < 4; ++ti) {
                    const bf16x8 af = *(const bf16x8*)(Pd + (16 * ti + lr) * PS + 32 * kk + 8 * lq);
                    ad[ti] = __builtin_amdgcn_mfma_f32_16x16x32_bf16(af, vb, ad[ti], 0, 0, 0);
                }
            }
#pragma unroll
            for (int kk = 0; kk < NKK; ++kk)
#pragma unroll
                for (int ti = 0; ti < 4; ++ti) {
                    const bf16x8 af = *(const bf16x8*)(Qn + (16 * ti + lr) * QS + 32 * kk + 8 * lq);
                    ai[ti] = __builtin_amdgcn_mfma_f32_16x16x32_bf16(af, sb[dd][kk], ai[ti], 0, 0, 0);
                }
#pragma unroll
            for (int ti = 0; ti < 4; ++ti)
#pragma unroll
                for (int r = 0; r < 4; ++r) {
                    const int tt = 16 * ti + 4 * lq + r;
                    float v = ad[ti][r] + __expf(BFB[dd * 64 + tt]) * ai[ti][r];
                    if (MIX == 0) v *= __builtin_amdgcn_rcpf(fmaxf(fabsf(DEN[dd * 64 + tt]), 1.0f));
                    acc_tot[ti][r] += v;
                }
        }
        __syncthreads();
    } else {
#pragma unroll 1
    for (int dir = 0; dir < 2; ++dir) {
        if constexpr (MIX == 1) {
            const int dd0 = g * 8;
            float ba[16];
            if (dir == 0) unpack16(rba[0], rba[1], ba); else unpack16(rba[2], rba[3], ba);
            const float* w2 = cx.a2_w + (size_t)dir * 16 * 256 + h * 64 + dd0;
            const float* b2 = cx.a2_b + dir * 256 + h * 64 + dd0;
            f32x4v a0 = *(const f32x4v*)b2, a1 = *(const f32x4v*)(b2 + 4);
#pragma unroll
            for (int r = 0; r < 16; ++r) { const f32x4v w0 = *(const f32x4v*)(w2 + r * 256), w1 = *(const f32x4v*)(w2 + r * 256 + 4); a0 += ba[r] * w0; a1 += ba[r] * w1; }
            f32x4v o0, o1;
#pragma unroll
            for (int i = 0; i < 4; ++i) { o0[i] = logsigf_(a0[i]) * 0.0625f; o1[i] = logsigf_(a1[i]) * 0.0625f; }
            *(f32x4v*)(Bm + t * BS + dd0) = o0; *(f32x4v*)(Bm + t * BS + dd0 + 4) = o1;
        } else if constexpr (MIX == 2) {
            float z[16], kk[16];
            if (dir == 0) unpack16(rz[0][0], rz[0][1], z); else unpack16(rz[1][0], rz[1][1], z);
            const f32x4v* om = (const f32x4v*)(cx.omlb + (cx.j * 2 + dir) * 512 + h * 128 + d0);
#pragma unroll
            for (int q4 = 0; q4 < 4; ++q4) {
                const f32x4v ov = om[q4]; f32x4v lo;
#pragma unroll
                for (int jx = 0; jx < 4; ++jx) {
                    const float E = __expf(fminf(-z[4 * q4 + jx], 80.f)), r = __builtin_amdgcn_rcpf(1.0f + E), ol = ov[jx];
                    lo[jx] = __logf(fmaxf((1.0f - ol) + ol * r, 1e-30f));
                    kk[4 * q4 + jx] = ol * E * r;
                }
                *(f32x4v*)(Bm + t * BS + d0 + 4 * q4) = lo;
            }
            store16(Kn + t * QS + d0, kk);
        }
        if constexpr (!scalar) __syncthreads();
        if constexpr (scalar) {
            if (w == 0) {
                float v = (MIX == 0) ? GT[(1 + 2 * dir) * 64 + lane] : lgam;
                if (dir == 0) {
#pragma unroll
                    for (int o = 1; o < 64; o <<= 1) { const float n = __shfl_up(v, o); if (lane >= o) v += n; }
                } else {
#pragma unroll
                    for (int o = 1; o < 64; o <<= 1) { const float n = __shfl_down(v, o); if (lane + o < 64) v += n; }
                }
                Bm[lane * BS] = v;
            }
        } else {
            const int d = tid & 127, sg = tid >> 7;
            if (d < dk) {
                float run = 0.f;
                if (dir == 0) {
#pragma unroll
                    for (int i = 0; i < 16; ++i) { const int tt = sg * 16 + i; run += Bm[tt * BS + d]; Bm[tt * BS + d] = run; } }
                else {
#pragma unroll
                    for (int i = 15; i >= 0; --i) { const int tt = sg * 16 + i; run += Bm[tt * BS + d]; Bm[tt * BS + d] = run; } }
                SEG[sg * 128 + d] = run;
            }
            __syncthreads();
            if (d < dk) {
                float off = 0.f;
                if (dir == 0) { for (int s2 = 0; s2 < sg; ++s2) off += SEG[s2 * 128 + d]; }
                else { for (int s2 = 3; s2 > sg; --s2) off += SEG[s2 * 128 + d]; }
#pragma unroll
                for (int i = 0; i < 16; ++i) Bm[(sg * 16 + i) * BS + d] += off;
            }
        }
        __syncthreads();

        const int tend = dir ? 0 : 63;
        const size_t slot = (size_t)c * 16 + head * 2 + dir;
        const float li = (MIX == 0) ? GT[(2 * dir) * 64 + t] : 0.f;
        if (MODE == 0) {
            u16* KT = Qs;
            if (16 * w < dk) {
                float kv[16]; unpack16(*(const u32x4v*)(Kn + lane * QS + 16 * w), *(const u32x4v*)(Kn + lane * QS + 16 * w + 8), kv);
                const float lis = (MIX == 0) ? GT[(2 * dir) * 64 + lane] : 0.f;
                if (scalar) {
                    const float e = expc(Bm[tend * BS] - Bm[lane * BS] + lis);
#pragma unroll
                    for (int i = 0; i < 16; ++i) kv[i] *= e;
                } else {
#pragma unroll
                    for (int q4 = 0; q4 < 4; ++q4) { const f32x4v be = *(const f32x4v*)(Bm + tend * BS + 16 * w + 4 * q4), bt = *(const f32x4v*)(Bm + lane * BS + 16 * w + 4 * q4);
#pragma unroll
                        for (int jx = 0; jx < 4; ++jx) kv[4 * q4 + jx] *= expc(be[jx] - bt[jx]); }
                }
#pragma unroll
                for (int i = 0; i < 8; ++i) { const unsigned pkd = pk2(kv[2 * i], kv[2 * i + 1]);
                    KT[(16 * w + 2 * i) * VTS + lane] = (u16)(pkd & 0xffffu); KT[(16 * w + 2 * i + 1) * VTS + lane] = (u16)(pkd >> 16); }
            }
            if (tid < 128) cx.DEC[slot * 128 + tid] = __expf(Bm[tend * BS + (scalar ? 0 : (tid < dk ? tid : 0))]);
            __syncthreads();
            if (MIX == 0 && tid < 128) {
                float s = 0.f;
#pragma unroll
                for (int q8 = 0; q8 < 8; ++q8) { float xv[16]; const u32x4v r = *(const u32x4v*)(KT + tid * VTS + 8 * q8); unpack16(r, r, xv);
#pragma unroll
                    for (int i = 0; i < 8; ++i) s += xv[i]; }
                cx.NV[((size_t)c * 8 + h * 2 + dir) * 128 + tid] = s;
            }
            bf16x8 vb[2];
#pragma unroll
            for (int kk = 0; kk < 2; ++kk) vb[kk] = *(const bf16x8*)(VT + (16 * w + lr) * VTS + 32 * kk + 8 * lq);
            u16* Sd = cx.ST + slot * 16384;
#pragma unroll 2
            for (int di = 0; di < dk / 16; ++di) {
                f32x4 a4 = (f32x4){0.f, 0.f, 0.f, 0.f};
#pragma unroll
                for (int kk = 0; kk < 2; ++kk) {
                    const bf16x8 af = *(const bf16x8*)(KT + (16 * di + lr) * VTS + 32 * kk + 8 * lq);
                    a4 = __builtin_amdgcn_mfma_f32_16x16x32_bf16(af, vb[kk], a4, 0, 0, 0);
                }
                u32x2v o; o[0] = pk2(a4[0], a4[1]); o[1] = pk2(a4[2], a4[3]);
                *(u32x2v*)(Sd + (16 * w + lr) * 128 + 16 * di + 4 * lq) = o;
            }
            __syncthreads();
        } else {
            const int tmid = 32;
            if (d0 < dk) {
                float qv[16], kv[16], a[16], bb[16], cc[16];
                unpack16(*(const u32x4v*)(Qn + t * QS + d0), *(const u32x4v*)(Qn + t * QS + d0 + 8), qv);
                unpack16(*(const u32x4v*)(Kn + t * QS + d0), *(const u32x4v*)(Kn + t * QS + d0 + 8), kv);
#pragma unroll
                for (int q4 = 0; q4 < 4; ++q4) { const f32x4v bmv = *(const f32x4v*)(Bm + tmid * BS + d0 + 4 * q4), bt = *(const f32x4v*)(Bm + t * BS + d0 + 4 * q4);
#pragma unroll
                    for (int jx = 0; jx < 4; ++jx) { const int i = 4 * q4 + jx; const float df = bt[jx] - bmv[jx];
                        a[i] = qv[i] * expc(df); bb[i] = kv[i] * expc(-df); cc[i] = qv[i] * __expf(bt[jx]); } }
                store16(Qs + t * QS + d0, a); store16(Ks + t * QS + d0, bb); store16(Qi + t * QS + d0, cc);
            }
            __syncthreads();
            {
                const int ti = w >> 1, tj0 = 2 * (w & 1);
                f32x4 sc[2] = {(f32x4){0.f, 0.f, 0.f, 0.f}, (f32x4){0.f, 0.f, 0.f, 0.f}};
#pragma unroll
                for (int kk = 0; kk < NKK; ++kk) {
                    const bf16x8 af = *(const bf16x8*)(Qs + (16 * ti + lr) * QS + 32 * kk + 8 * lq);
#pragma unroll
                    for (int jj = 0; jj < 2; ++jj) {
                        const bf16x8 bfr = *(const bf16x8*)(Ks + (16 * (tj0 + jj) + lr) * QS + 32 * kk + 8 * lq);
                        sc[jj] = __builtin_amdgcn_mfma_f32_16x16x32_bf16(af, bfr, sc[jj], 0, 0, 0);
                    }
                }
#pragma unroll
                for (int jj = 0; jj < 2; ++jj)
#pragma unroll
                    for (int r = 0; r < 4; ++r) {
                        const int tt = 16 * ti + 4 * lq + r, ss = 16 * (tj0 + jj) + lr;
                        const bool keep = dir ? (ss >= tt) : (ss <= tt);
                        Pm[tt * PS + ss] = (u16)(pk2(keep ? sc[jj][r] : 0.f, 0.f) & 0xffffu);
                    }
            }
            __syncthreads();
            f32x4 ad[4];
#pragma unroll
            for (int i = 0; i < 4; ++i) ad[i] = (f32x4){0.f, 0.f, 0.f, 0.f};
#pragma unroll
            for (int kk = 0; kk < 2; ++kk) {
                const bf16x8 vb = *(const bf16x8*)(VT + (16 * w + lr) * VTS + 32 * kk + 8 * lq);
#pragma unroll
                for (int ti = 0; ti < 4; ++ti) {
                    const bf16x8 af = *(const bf16x8*)(Pm + (16 * ti + lr) * PS + 32 * kk + 8 * lq);
                    ad[ti] = __builtin_amdgcn_mfma_f32_16x16x32_bf16(af, vb, ad[ti], 0, 0, 0);
                }
            }
#pragma unroll
            for (int kk = 0; kk < NKK; ++kk)
#pragma unroll
                for (int ti = 0; ti < 4; ++ti) {
                    const bf16x8 af = *(const bf16x8*)(Qi + (16 * ti + lr) * QS + 32 * kk + 8 * lq);
                    ad[ti] = __builtin_amdgcn_mfma_f32_16x16x32_bf16(af, dir ? sb[1][kk] : sb[0][kk], ad[ti], 0, 0, 0);
                }
#pragma unroll
            for (int ti = 0; ti < 4; ++ti) acc_tot[ti] += ad[ti];
            __syncthreads();
        }
    }
    }

    if (MODE == 1) {
        float* Ot = Bm;
#pragma unroll
        for (int ti = 0; ti < 4; ++ti)
#pragma unroll
            for (int r = 0; r < 4; ++r) Ot[(16 * ti + 4 * lq + r) * BS + 16 * w + lr] = acc_tot[ti][r];
        __syncthreads();
        float ov[16];
#pragma unroll
        for (int q4 = 0; q4 < 4; ++q4) { const f32x4v x = *(const f32x4v*)(Ot + t * BS + d0 + 4 * q4); ov[4 * q4] = x[0]; ov[4 * q4 + 1] = x[1]; ov[4 * q4 + 2] = x[2]; ov[4 * q4 + 3] = x[3]; }
        float s1 = 0.f, s2 = 0.f;
#pragma unroll
        for (int i = 0; i < 16; ++i) { s1 += ov[i]; s2 += ov[i] * ov[i]; }
        s1 += __shfl_xor(s1, 1); s2 += __shfl_xor(s2, 1); s1 += __shfl_xor(s1, 2); s2 += __shfl_xor(s2, 2); s1 += __shfl_xor(s1, 4); s2 += __shfl_xor(s2, 4);
        constexpr bool lnorm = (MIX == 0 || MIX == 3);
        const float mean_ = s1 * (1.f / 128.f), ex2 = s2 * (1.f / 128.f);
        const float mu = lnorm ? mean_ : 0.f;
        const float rs = rsqrtf((lnorm ? fmaxf(ex2 - mean_ * mean_, 0.f) : ex2) + 1e-5f);
        const int hcol = ((MIX & 1) ? 512 : 0) + h * 128 + d0;
        float gv[16]; unpack16(rg[0], rg[1], gv);
        float nw[16];
        if constexpr (MIX != 3) {
            const float* nwp = cx.norm_w + hcol;
#pragma unroll
            for (int q4 = 0; q4 < 4; ++q4) { const f32x4v x = *(const f32x4v*)(nwp + 4 * q4); nw[4 * q4] = x[0]; nw[4 * q4 + 1] = x[1]; nw[4 * q4 + 2] = x[2]; nw[4 * q4 + 3] = x[3]; }
        } else {
#pragma unroll
            for (int i = 0; i < 16; ++i) nw[i] = 1.f;
        }
#pragma unroll
        for (int i = 0; i < 16; ++i) {
            const float sg = __builtin_amdgcn_rcpf(1.0f + __expf(-gv[i]));
            const float gate = (MIX == 0) ? sg : gv[i] * sg;
            ov[i] = (ov[i] - mu) * rs * nw[i] * gate;
        }
        store16(cx.H + (row0 + t) * DM + hcol, ov);
        __syncthreads();
    }
}

template <int MODE>
__device__ __forceinline__ void phase_scan(const ScanCtx& cx, unsigned char* shm) {
    const int b = obid();
    if (cx.even) {
#pragma unroll 1
        for (int v = b; v < 1024; v += gridDim.x) scan_unit<MODE, 0>(cx, v >> 2, v & 3, shm);
#pragma unroll 1
        for (int v = b; v < 1024; v += gridDim.x) scan_unit<MODE, 1>(cx, v >> 2, v & 3, shm);
    } else {
#pragma unroll 1
        for (int v = b; v < 1024; v += gridDim.x) scan_unit<MODE, 2>(cx, v >> 2, v & 3, shm);
#pragma unroll 1
        for (int v = b; v < 1024; v += gridDim.x) scan_unit<MODE, 3>(cx, v >> 2, v & 3, shm);
    }
}

__device__ void phase_scan_prefix(const ScanCtx& cx, bool dry) {
    const int tid = otid();
    const int nseq = 256 / cx.cps;
    const int nunits = nseq * 16 * 16;
    for (int u = blockIdx.x; u < nunits; u += gridDim.x) {
        const int chain = u >> 4, sub = u & 15;
        const int seq = chain >> 4, hd = chain & 15, head = hd >> 1, dir = hd & 1;
        const int idx = sub * 512 + tid, e = idx >> 6, d = (idx & 63) * 2;
        const int dk = (cx.even && head >= 4) ? 64 : 128;
        const int cbase = seq * cx.cps, n = cx.cps;
        if (d < dk) {
            float s0 = 0.f, s1 = 0.f;
#pragma unroll 1
            for (int i0 = 0; i0 < n; i0 += 32) {
                unsigned wv[32]; f32x2c dc[32];
#pragma unroll
                for (int k = 0; k < 32; ++k) {
                    const int c = dir ? (cbase + n - 1 - (i0 + k)) : (cbase + i0 + k);
                    const size_t slot = (size_t)c * 16 + hd;
                    wv[k] = *(const unsigned*)(cx.ST + slot * 16384 + e * 128 + d);
                    dc[k] = *(const f32x2c*)(cx.DEC + slot * 128 + d);
                }
#pragma unroll
                for (int k = 0; k < 32; ++k) {
                    const int c = dir ? (cbase + n - 1 - (i0 + k)) : (cbase + i0 + k);
                    const size_t slot = (size_t)c * 16 + hd;
                    *(unsigned*)(cx.ST + slot * 16384 + e * 128 + d) = dry ? wv[k] : pk2(s0, s1);
                    s0 = dc[k][0] * s0 + __uint_as_float(wv[k] << 16);
                    s1 = dc[k][1] * s1 + __uint_as_float(wv[k] & 0xffff0000u);
                }
            }
        }
        if (cx.even && head < 4 && sub == 0 && tid < 128) {
            float s = 0.f;
#pragma unroll 1
            for (int i0 = 0; i0 < n; i0 += 8) {
                float dl[8], dc[8];
#pragma unroll
                for (int k = 0; k < 8; ++k) {
                    const int c = dir ? (cbase + n - 1 - (i0 + k)) : (cbase + i0 + k);
                    dl[k] = cx.NV[((size_t)c * 8 + head * 2 + dir) * 128 + tid];
                    dc[k] = cx.DEC[((size_t)c * 16 + hd) * 128 + tid];
                }
#pragma unroll
                for (int k = 0; k < 8; ++k) {
                    const int c = dir ? (cbase + n - 1 - (i0 + k)) : (cbase + i0 + k);
                    cx.NV[((size_t)c * 8 + head * 2 + dir) * 128 + tid] = dry ? dl[k] : s;
                    s = dc[k] * s + dl[k];
                }
            }
        }
    }
}

constexpr int PH_PER_LAYER = 31, N_PHASES = 1 + 4 * PH_PER_LAYER;

__device__ void run_phase(const Params& p, int ph, unsigned char* shm, bool dry) {
    if (ph == 0) { phase_prep(p, shm); return; }
    const int l = (ph - 1) / PH_PER_LAYER, s = (ph - 1) % PH_PER_LAYER, j = l >> 1, even = !(l & 1);
    u16* XB = (u16*)(p.ws + WS_XB);
    if (s < 5 || s >= 26) {
        const int which = (s >= 26), ss = which ? s - 26 : s;
        if (ss == 4) { phase_ln(p, p.in[6] + (l * 3 + (which ? 2 : 0)) * DM, p.in[7] + (l * 3 + (which ? 2 : 0)) * DM, which && l == 3); return; }
        const int half = ss >> 1;
        u16* ACT = (u16*)(p.ws + WS_ACT);
        if ((ss & 1) == 0) {
            EpiSwiGLU E; E.O = ACT; E.ldc = DFF;
            run_gemm(shm, XB + (size_t)half * HALF_ROWS * DM, (const u16*)(p.ws + WS_FFN_IN + (size_t)(which * 4 + l) * SZ_FFN_IN), HALF_ROWS, 5632, 1024, E);
        } else {
            EpiResid E; E.X = p.X + (size_t)half * HALF_ROWS * DM; E.src = E.X; E.scale = 0.5f; E.dry = dry;
            const int lnidx = which ? (l * 3 + 1) : (l * 3 - 1);
            if (lnidx < 0) { E.stats = nullptr; E.g = nullptr; E.b = nullptr; E.src = p.in[half]; }
            else { E.stats = (const float*)(p.ws + WS_STATS) + 2 * (size_t)half * HALF_ROWS; E.g = p.in[6] + lnidx * DM; E.b = p.in[7] + lnidx * DM; }
            run_gemm(shm, ACT, (const u16*)(p.ws + WS_FFN_OUT + (size_t)(which * 4 + l) * SZ_FFN_OUT), HALF_ROWS, 1024, DFF, E);
        }
        return;
    }
    if (s == 25) { phase_ln(p, p.in[6] + (l * 3 + 1) * DM, p.in[7] + (l * 3 + 1) * DM, false); return; }
    const int q = (s - 5) / 5, k = (s - 5) % 5;
    ScanCtx cx;
    cx.Y = (const u16*)(p.ws + WS_Y); cx.ld = even ? EVC : ODC;
    cx.H = XB + (size_t)q * Q_ROWS * DM;
    cx.ST = (u16*)(p.ws + WS_ST); cx.DEC = (float*)(p.ws + WS_DEC); cx.NV = (float*)(p.ws + WS_NV);
    cx.cps = (q < 2) ? 256 : 64; cx.even = even; cx.j = j;
    cx.gate_b = p.in[9] + j * 16; cx.conv_w = p.in[10] + j * 5 * 1024; cx.a2_w = p.in[11] + (size_t)j * 2 * 16 * 256; cx.a2_b = p.in[12] + j * 2 * 256;
    cx.norm_w = even ? (p.in[13] + j * 1024) : (p.in[17] + j * 512);
    cx.lb_logits = p.in[16];
    cx.rope = (const double*)(p.ws + WS_ROPE); cx.omlb = (const float*)(p.ws + WS_OMLB);
    if (k == 0) {
        EpiBf16 E; E.O = (u16*)(p.ws + WS_Y); E.ldc = cx.ld;
        const u16* Bt = even ? (const u16*)(p.ws + WS_EV_IN + (size_t)j * SZ_EV_IN) : (const u16*)(p.ws + WS_OD_IN + (size_t)j * SZ_OD_IN);
        run_gemm(shm, XB + (size_t)q * Q_ROWS * DM, Bt, Q_ROWS, cx.ld, 1024, E);
    } else if (k == 1) {
        phase_scan<0>(cx, shm);
    } else if (k == 2) {
        phase_scan_prefix(cx, dry);
    } else if (k == 3) {
        phase_scan<1>(cx, shm);
    } else {
        EpiResid E; E.X = p.X; E.src = E.X; E.scale = 1.0f; E.dry = dry;
        E.stats = (const float*)(p.ws + WS_STATS); E.g = p.in[6] + (l * 3) * DM; E.b = p.in[7] + (l * 3) * DM;
        const u16* Bt = even ? (const u16*)(p.ws + WS_EV_OUT + (size_t)j * SZ_SQ) : (const u16*)(p.ws + WS_OD_OUT + (size_t)j * SZ_SQ);
        run_gemm(shm, XB, Bt, NTOK, 1024, 1024, E);
    }
}

#ifndef PROBE_MASK
#define PROBE_MASK 0
#endif
__device__ __forceinline__ bool probe_repeat(int ph) {
    if (ph == 0) return (PROBE_MASK & 4) != 0;
    const int s = (ph - 1) % PH_PER_LAYER;
    if (s < 5 || s >= 26) { const int ss = s >= 26 ? s - 26 : s; if (ss == 4) return (PROBE_MASK & 16) && !(s >= 26 && (ph - 1) / PH_PER_LAYER == 3); if (ss == 1 || ss == 3) return (PROBE_MASK & 64) && (ph > 5); return (PROBE_MASK & 2) && (ss == 0 || ss == 2); }
    if (s == 25) return (PROBE_MASK & 16) != 0;
    const int k = (s - 5) % 5;
    if (k == 0) return (PROBE_MASK & 2) != 0;
    if (k == 1 || k == 3) return (PROBE_MASK & 1) != 0;
    if (k == 2) return (PROBE_MASK & 32) != 0;
    if (k == 4) return (PROBE_MASK & 64) != 0;
    return false;
}
constexpr size_t WS_BAR = WS_STATS + (size_t)NTOK * 8;
constexpr size_t LDS_MAIN = SCAN_LDS > 131072 ? SCAN_LDS : 131072;
__device__ __forceinline__ bool phase_is_noop(int ph) {
    if (ph == 0) return false;
    const int s = (ph - 1) % PH_PER_LAYER;
    return s >= 5 && s < 25 && ((s - 5) % 5) == 4 && ((s - 5) / 5) < 3;
}
template <bool COOP>
__global__ __launch_bounds__(512, 2) void hybrid_mega(Params p, int ph0, int ph1) {
    extern __shared__ __attribute__((aligned(16))) unsigned char shm[];
    volatile LAS unsigned* st = (volatile LAS unsigned*)((LAS unsigned char*)shm + LDS_MAIN);
    if (threadIdx.x == 0) { st[0] = 0u; st[1] = 0u; st[2] = 0u; st[3] = 0u; }
    __syncthreads();
    XcdBarrier xb = xcd_barrier_post((unsigned*)(p.ws + WS_BAR), st);
    for (int ph = ph0; ph < ph1; ++ph) {
        if (phase_is_noop(ph)) continue;
#if PROBE_MASK
        const int nrep = probe_repeat(ph) ? 2 : 1;
#pragma unroll 1
        for (int rep = 0; rep < nrep; ++rep) {
            run_phase(p, ph, shm, rep > 0);
            if (COOP) { if (ph == 0 && rep == 0) cg::this_grid().sync(); else xcd_barrier(xb); }
            if (PROBE_MASK & 8) { if (COOP) xcd_barrier(xb); }
        }
#else
        run_phase(p, ph, shm, false);
        if (COOP && ph + 1 < ph1) { if (ph == 0) cg::this_grid().sync(); else xcd_barrier(xb); }
#endif
    }
}

#ifndef USE_COOP
#define USE_COOP 1
#endif

extern "C" void kernel_launch(void* const* d_in, const int* in_sizes, int n_in, void* d_out, int out_size, void* d_ws, size_t ws_size, hipStream_t stream) {
    (void)in_sizes; (void)n_in; (void)out_size; (void)ws_size;
    Params p{};
    for (int i = 0; i < 19; ++i) p.in[i] = (const float*)d_in[i];
    p.X = (float*)d_out; p.ws = (unsigned char*)d_ws;
    constexpr size_t kLds = LDS_MAIN + 16;
#if USE_COOP
    static int grid_blocks = 0;
    if (!grid_blocks) {
        hipFuncSetAttribute((const void*)hybrid_mega<true>, hipFuncAttributeMaxDynamicSharedMemorySize, (int)kLds);
        int dev = 0, cus = 0, per_cu = 0;
        hipGetDevice(&dev);
        hipDeviceGetAttribute(&cus, hipDeviceAttributeMultiprocessorCount, dev);
        hipOccupancyMaxActiveBlocksPerMultiprocessor(&per_cu, hybrid_mega<true>, 512, kLds);
        if (per_cu < 1) per_cu = 1;
        grid_blocks = cus * 1;
    }
    hipMemsetAsync((unsigned char*)d_ws + WS_BAR, 0, XCD_BAR_WORDS * sizeof(unsigned), stream);
    int ph0 = 0, ph1 = N_PHASES;
    void* args[] = {&p, &ph0, &ph1};
    hipLaunchCooperativeKernel((const void*)hybrid_mega<true>, dim3(grid_blocks), dim3(512), args, kLds, stream);
#else
    static int inited = 0;
    if (!inited) { hipFuncSetAttribute((const void*)hybrid_mega<false>, hipFuncAttributeMaxDynamicSharedMemorySize, (int)kLds); inited = 1; }
    for (int ph = 0; ph < N_PHASES; ++ph) hybrid_mega<false><<<256, 512, kLds, stream>>>(p, ph, ph + 1);
#endif
}
```

```cpp
#define PROBE_MASK 0
#include <hip/hip_runtime.h>
#include <hip/hip_cooperative_groups.h>
namespace pg8 {
#define PG8_LAS __attribute__((address_space(3)))
typedef unsigned short bf16_t;
typedef short bf16x8 __attribute__((ext_vector_type(8)));
typedef float f32x4 __attribute__((ext_vector_type(4)));
typedef unsigned u32x4 __attribute__((ext_vector_type(4)));
constexpr int BM = 256, BK = 64, HALF = 128, HTB = HALF * BK * 2  , STAGE_BYTES = 8 * HTB, NXCD = 8, WGM = 8;

__host__ __device__ __forceinline__ int lds_byte(int r, int c) { const int st = (r >> 4) * 2 + (c >> 5), rr = r & 15, cc = c & 31, ob = rr * 64 + cc * 2; return st * 1024 + (ob ^ (((ob >> 9) & 1) << 5)); }
__host__ __device__ __forceinline__ void stage_rc(int b, int& R, int& C) { const int st = b / 1024, sb = b % 1024, swz = sb ^ (((sb >> 9) & 1) << 5); R = (st >> 1) * 16 + swz / 64; C = (st & 1) * 32 + (swz % 64) / 2; }
__host__ __device__ __forceinline__ int perm32(int rho) { const int n = rho >> 4, i = rho & 15; return 8 * (i >> 2) + 4 * n + (i & 3); }

struct Unit { int pm, pn; };
struct Gemm { const bf16_t* A; const bf16_t* Bt; int M, N, K; };

struct StaticOrder {
    int nM, nN, nwg, G, c;
    __host__ __device__ void init(int M, int N, int G_, int c_) { nM = M / BM; nN = N / BM; nwg = nM * nN; G = G_; c = c_; }
    __host__ __device__ bool next(int i, Unit& u) const {
        const long L = (long)i * G + c; if (L >= nwg) return false;
        int wgid = (int)L; { const int q = nwg / NXCD, r = nwg % NXCD, xcd = wgid % NXCD, off = wgid / NXCD; wgid = (xcd < r ? xcd * (q + 1) : r * (q + 1) + (xcd - r) * q) + off; }
        const int nig = WGM * nN, gid = wgid / nig, fm = gid * WGM, gsz = (nM - fm) < WGM ? (nM - fm) : WGM;
        u.pm = fm + ((wgid % nig) % gsz); u.pn = (wgid % nig) / gsz; return true;
    }
    __device__ __forceinline__ void a_ready(const Unit&) const {}
    __device__ __forceinline__ void done(const Unit&) const {}
};
__device__ __forceinline__ unsigned cvt_pk_bf16(float lo, float hi) { unsigned r; asm volatile("v_cvt_pk_bf16_f32 %0, %1, %2" : "=v"(r) : "v"(lo), "v"(hi)); return r; }

template <class Epi, class Sched, bool STAMP = false>
__device__ __forceinline__ void gemm_phase(PG8_LAS unsigned char* lds, const Gemm g, const Sched& S, const Epi& E, unsigned long long* stamps) {
    int tid_o = threadIdx.x; asm volatile("" : "+v"(tid_o)); const int tid = tid_o, wid = __builtin_amdgcn_readfirstlane(tid >> 6), lane = tid & 63, wr = wid >> 2, wc = wid & 3, fr = lane & 15, fq = lane >> 4;
    const int K = g.K, nt = K / BK;
    int ts_lo = 0, ts_hi = 0, nts = 0; const unsigned long long rt_entry = STAMP ? (unsigned long long)wall_clock64() : 0ull;
#define PG8_STAMP() do { if (STAMP && wid == 0 && nts < 64) { const unsigned long long _c = (unsigned long long)clock64(); \
        ts_lo = (lane == nts) ? (int)(unsigned)_c : ts_lo; ts_hi = (lane == nts) ? (int)(unsigned)(_c >> 32) : ts_hi; ++nts; } } while (0)
    PG8_STAMP();
    unsigned voffA[2], voffB[2];
#pragma unroll
    for (int i = 0; i < 2; ++i) { int R, C; stage_rc(tid * 16 + i * 8192, R, C); const int Rb = Epi::PERM ? ((R & ~31) + perm32(R & 31)) : R;
        voffA[i] = (unsigned)(R * K + C) * 2u; voffB[i] = (unsigned)(Rb * K + C) * 2u; }
    const size_t kstep = (size_t)(BK * 2);
    const size_t hstep = (size_t)HALF * K * 2;
    const size_t tstep = 2 * hstep;
    const unsigned ldsw = (unsigned)wid * 1024u;
    const int aoff = lds_byte(wr * 64 + fr, fq * 8), boff = lds_byte(wc * 32 + fr, fq * 8);
#define PG8_SA(b, h) (((b) * 2 + (h)) * HTB)
#define PG8_SB(b, h) ((4 + (b) * 2 + (h)) * HTB)
#define PG8_STAGE(bufoff, gbase, voff) do { _Pragma("unroll") for (int _i = 0; _i < 2; ++_i) \
        __builtin_amdgcn_global_load_lds((const unsigned*)((const char*)(gbase) + (voff)[_i]), (PG8_LAS unsigned*)(lds + (bufoff) + ldsw + _i * 8192), 16, 0, 0); } while (0)
#define PG8_LDA(dst, b, h) do { _Pragma("unroll") for (int m = 0; m < 4; ++m) _Pragma("unroll") for (int k = 0; k < 2; ++k) dst[m][k] = *(const PG8_LAS bf16x8*)(lds + PG8_SA(b, h) + aoff + m * 2048 + k * 1024); } while (0)
#define PG8_LDB(dst, b, h) do { _Pragma("unroll") for (int n = 0; n < 2; ++n) _Pragma("unroll") for (int k = 0; k < 2; ++k) dst[n][k] = *(const PG8_LAS bf16x8*)(lds + PG8_SB(b, h) + boff + n * 2048 + k * 1024); } while (0)
#define PG8_MMA(ai, bj, At, Bt) do { __builtin_amdgcn_s_setprio(1); _Pragma("unroll") for (int m = 0; m < 4; ++m) _Pragma("unroll") for (int n = 0; n < 2; ++n) _Pragma("unroll") for (int k = 0; k < 2; ++k) \
        acc[ai][bj][m][n] = __builtin_amdgcn_mfma_f32_16x16x32_bf16(Bt[n][k], At[m][k], acc[ai][bj][m][n], 0, 0, 0); __builtin_amdgcn_s_setprio(0); } while (0)
#define PG8_WAIT_V(n) asm volatile("s_waitcnt vmcnt(" #n ")" ::: "memory")
#define PG8_WAIT_L(n) asm volatile("s_waitcnt lgkmcnt(" #n ")" ::: "memory")
#define PG8_BAR __builtin_amdgcn_s_barrier()
#define PG8_SCHED __builtin_amdgcn_sched_barrier(0)
    Unit cur, nxt; int ui = 0;
    if (!S.next(0, cur)) return;
    f32x4 acc[2][2][4][2];
#pragma unroll
    for (int a = 0; a < 2; ++a)
#pragma unroll
        for (int b = 0; b < 2; ++b)
#pragma unroll
            for (int m = 0; m < 4; ++m)
#pragma unroll
                for (int n = 0; n < 2; ++n) { if constexpr (Epi::HAS_INIT) acc[a][b][m][n] = E.init(cur, wr, wc, fr, fq, a, b, m, n); else acc[a][b][m][n] = (f32x4){0.f, 0.f, 0.f, 0.f}; }
    bf16x8 At[4][2], B0[2][2], B1[2][2];
    const char* cA = (const char*)g.A + (size_t)cur.pm * tstep; const char* cB = (const char*)g.Bt + (size_t)cur.pn * tstep;
    S.a_ready(cur);
    PG8_STAGE(PG8_SB(0, 0), cB, voffB); PG8_STAGE(PG8_SA(0, 0), cA, voffA); PG8_STAGE(PG8_SB(0, 1), cB + hstep, voffB); PG8_STAGE(PG8_SA(0, 1), cA + hstep, voffA);
    if (wr == 1) PG8_BAR;
    PG8_WAIT_V(4); PG8_BAR;
    PG8_STAGE(PG8_SB(1, 0), cB + kstep, voffB); PG8_STAGE(PG8_SA(1, 0), cA + kstep, voffA); PG8_STAGE(PG8_SB(1, 1), cB + hstep + kstep, voffB);
    PG8_WAIT_V(6); PG8_BAR;
    PG8_STAMP();
    for (;;) {
        const bool has_next = S.next(ui + 1, nxt);
        const char* nA = has_next ? (const char*)g.A + (size_t)nxt.pm * tstep : cA; const char* nB = has_next ? (const char*)g.Bt + (size_t)nxt.pn * tstep : cB;
        for (int t = 0; t < nt; t += 2) {
            const bool last = (t == nt - 2);
            const char* a1 = cA + (size_t)(t + 1) * kstep;
            const char* a2 = last ? nA : cA + (size_t)(t + 2) * kstep; const char* b2 = last ? nB : cB + (size_t)(t + 2) * kstep;
            const char* a3 = a2 + kstep; const char* b3 = b2 + kstep;
            if (last && has_next) S.a_ready(nxt);
            PG8_LDB(B0, 0, 0); PG8_SCHED; PG8_LDA(At, 0, 0); PG8_STAGE(PG8_SA(1, 1), a1 + hstep, voffA);
            PG8_WAIT_L(8); PG8_BAR; PG8_WAIT_L(0); PG8_MMA(0, 0, At, B0); PG8_BAR; PG8_SCHED;
            PG8_LDB(B1, 0, 1); PG8_STAGE(PG8_SB(0, 0), b2, voffB);
            PG8_BAR; PG8_WAIT_L(0); PG8_MMA(0, 1, At, B1); PG8_BAR;
            PG8_LDA(At, 0, 1); PG8_STAGE(PG8_SA(0, 0), a2, voffA);
            PG8_BAR; PG8_WAIT_L(0); PG8_MMA(1, 0, At, B0); PG8_BAR; PG8_SCHED;
            PG8_STAGE(PG8_SB(0, 1), b2 + hstep, voffB);
            PG8_WAIT_V(6); PG8_BAR; PG8_MMA(1, 1, At, B1); PG8_BAR;
            PG8_LDB(B0, 1, 0); PG8_SCHED; PG8_LDA(At, 1, 0); PG8_STAGE(PG8_SA(0, 1), a2 + hstep, voffA);
            PG8_WAIT_L(8); PG8_BAR; PG8_WAIT_L(0); PG8_MMA(0, 0, At, B0); PG8_BAR; PG8_SCHED;
            PG8_LDB(B1, 1, 1); PG8_STAGE(PG8_SB(1, 0), b3, voffB);
            PG8_BAR; PG8_WAIT_L(0); PG8_MMA(0, 1, At, B1); PG8_BAR;
            PG8_LDA(At, 1, 1); PG8_STAGE(PG8_SA(1, 0), a3, voffA);
            PG8_BAR; PG8_WAIT_L(0); PG8_MMA(1, 0, At, B0); PG8_BAR; PG8_SCHED;
            PG8_STAGE(PG8_SB(1, 1), b3 + hstep, voffB);
            PG8_WAIT_V(6); PG8_BAR; PG8_MMA(1, 1, At, B1); PG8_BAR;
        }
        PG8_STAMP();
        if constexpr (!Epi::AFTER_DRAIN) { E(acc, cur, wr, wc, fr, fq); S.done(cur); }
        PG8_STAMP();
        if (!has_next) break;
#pragma unroll
        for (int a = 0; a < 2; ++a)
#pragma unroll
            for (int b = 0; b < 2; ++b)
#pragma unroll
                for (int m = 0; m < 4; ++m)
#pragma unroll
                    for (int n = 0; n < 2; ++n) { if constexpr (Epi::HAS_INIT) acc[a][b][m][n] = E.init(nxt, wr, wc, fr, fq, a, b, m, n); else acc[a][b][m][n] = (f32x4){0.f, 0.f, 0.f, 0.f}; }
        cur = nxt; cA = nA; cB = nB; ++ui;
    }
    PG8_WAIT_V(0);
    if (wr == 0) PG8_BAR;
    PG8_BAR;
    if constexpr (Epi::AFTER_DRAIN) { E.fused(acc, cur, wr, wc, fr, fq, lds, wid, lane); S.done(cur); }
    PG8_STAMP();
    if (STAMP && wid == 0) { stamps[lane] = lane < nts ? (((unsigned long long)(unsigned)ts_hi << 32) | (unsigned)ts_lo) : 0ull;
        if (lane == 62) stamps[62] = rt_entry; if (lane == 63) stamps[63] = (unsigned long long)wall_clock64(); }
#undef PG8_STAMP
#undef PG8_SA
#undef PG8_SB
#undef PG8_STAGE
#undef PG8_LDA
#undef PG8_LDB
#undef PG8_MMA
#undef PG8_WAIT_V
#undef PG8_WAIT_L
#undef PG8_BAR
#undef PG8_SCHED
}
}
#define XB_TMO      128
#define XB_XCNT(j)  (256  + 64 * (j))
#define XB_XSUB(j)  (1280 + 64 * (j))
#define XB_XGEN(j)  (2304 + 64 * (j))
#define XB_TOP      3328
#define XB_TOPGEN   3392
#define XCD_BAR_WORDS 3456
#define XB_SPIN_CAP (1u << 18)
#define LAS __attribute__((address_space(3)))

__device__ __forceinline__ unsigned xb_ld(unsigned* p)              { return __hip_atomic_load(p, __ATOMIC_RELAXED, __HIP_MEMORY_SCOPE_AGENT); }
__device__ __forceinline__ unsigned xb_add(unsigned* p, unsigned v) { return __hip_atomic_fetch_add(p, v, __ATOMIC_RELAXED, __HIP_MEMORY_SCOPE_AGENT); }
__device__ __forceinline__ unsigned xb_xcc_id() { return (unsigned)__builtin_amdgcn_s_getreg((3 << 11) | 20) & 0xFu; }
#define XB_SPIN(cond, bar) do { unsigned _sp = 0; while (cond) { __builtin_amdgcn_s_sleep(1); \
    if ((++_sp & 255u) == 0u) { if (xb_ld(&(bar)[XB_TMO])) break; if (_sp > XB_SPIN_CAP) { atomicAdd(&(bar)[XB_TMO], 1u); break; } } } } while (0)

struct XcdBarrier {
    unsigned* bar; unsigned x;
    volatile LAS unsigned* st;
};

__device__ __forceinline__ XcdBarrier xcd_barrier_post(unsigned* bar, volatile LAS unsigned* st) {
    XcdBarrier b; b.bar = bar; b.x = xb_xcc_id(); b.st = st;
    if (threadIdx.x == 0) (void)xb_add(&bar[XB_XCNT(b.x)], 1u);
    return b;
}
__device__ __forceinline__ void xcd_barrier_complete(unsigned* bar, unsigned x, unsigned& nloc, unsigned& nx) {
    const unsigned G = gridDim.x * gridDim.y * gridDim.z;
    unsigned sum, cnt, mine, sp = 0u;
    for (;;) {
        sum = 0u; cnt = 0u; mine = 0u;
#pragma unroll
        for (unsigned j = 0; j < 16; ++j) { const unsigned c = xb_ld(&bar[XB_XCNT(j)]); sum += c; cnt += (c > 0u) ? 1u : 0u; mine = (j == x) ? c : mine; }
        if (sum == G) break;
        __builtin_amdgcn_s_sleep(1);
        if ((++sp & 255u) == 0u) { if (xb_ld(&bar[XB_TMO])) break; if (sp > XB_SPIN_CAP) { atomicAdd(&bar[XB_TMO], 1u); break; } }
    }
    nloc = mine > 0u ? mine : 1u; nx = cnt > 0u ? cnt : 1u;
}

__device__ __forceinline__ void xcd_barrier(const XcdBarrier& b) {
    asm volatile("s_waitcnt vmcnt(0)" ::: "memory");
    __syncthreads();
    if (threadIdx.x == 0) {
        unsigned* bar = b.bar;
        __builtin_amdgcn_s_waitcnt(0);
        unsigned nloc = b.st[0], nx = b.st[1];
        if (nloc == 0u) { xcd_barrier_complete(bar, b.x, nloc, nx); b.st[0] = nloc; b.st[1] = nx; }
        const unsigned old = xb_add(&bar[XB_XSUB(b.x)], 1u);
        const unsigned gen = old / nloc;
        if (old + 1u == (gen + 1u) * nloc) {
            __builtin_amdgcn_fence(__ATOMIC_RELEASE, "agent");
            asm volatile("s_waitcnt vmcnt(0)" ::: "memory");
            const unsigned og = xb_add(&bar[XB_TOP], 1u);
            const unsigned tg = og / nx;
            if (og + 1u == (tg + 1u) * nx) xb_add(&bar[XB_TOPGEN], 1u);
            else XB_SPIN(xb_ld(&bar[XB_TOPGEN]) == tg, bar);
            __builtin_amdgcn_fence(__ATOMIC_ACQUIRE, "agent");
            xb_add(&bar[XB_XGEN(b.x)], 1u);
            asm volatile("s_waitcnt vmcnt(0)" ::: "memory");
        } else {
            XB_SPIN(xb_ld(&bar[XB_XGEN(b.x)]) == gen, bar);
            __builtin_amdgcn_fence(__ATOMIC_ACQUIRE, "agent");
            asm volatile("s_waitcnt vmcnt(0)" ::: "memory");
        }
    }
    __syncthreads();
}

namespace cg = cooperative_groups;
__device__ __forceinline__ int otid() { int t = threadIdx.x; asm volatile("" : "+v"(t)); return t; }
__device__ __forceinline__ int obid() { int b = blockIdx.x; asm volatile("" : "+s"(b)); return b; }
typedef unsigned short u16;
using pg8::bf16x8; using pg8::f32x4;
typedef unsigned u32x4v __attribute__((ext_vector_type(4)));
typedef unsigned u32x2v __attribute__((ext_vector_type(2)));
typedef float f32x4v __attribute__((ext_vector_type(4)));

constexpr int NTOK = 65536, DM = 1024, DFF = 2816;
constexpr int EVC = 3840, ODC = 4608;
constexpr float ALPHA_F = 1.681792830507429f;
constexpr int HALF_ROWS = 32768, Q_ROWS = 16384;

constexpr size_t SZ_FFN_IN = (size_t)5632 * 1024 * 2, SZ_FFN_OUT = (size_t)1024 * 2816 * 2;
constexpr size_t SZ_EV_IN = (size_t)EVC * 1024 * 2, SZ_OD_IN = (size_t)ODC * 1024 * 2, SZ_SQ = (size_t)1024 * 1024 * 2;
constexpr size_t WS_FFN_IN = 0;
constexpr size_t WS_FFN_OUT = WS_FFN_IN + 8 * SZ_FFN_IN;
constexpr size_t WS_EV_IN = WS_FFN_OUT + 8 * SZ_FFN_OUT;
constexpr size_t WS_OD_IN = WS_EV_IN + 2 * SZ_EV_IN;
constexpr size_t WS_EV_OUT = WS_OD_IN + 2 * SZ_OD_IN;
constexpr size_t WS_OD_OUT = WS_EV_OUT + 2 * SZ_SQ;
constexpr size_t WS_XB = WS_OD_OUT + 2 * SZ_SQ;
constexpr size_t WS_ROPE = WS_XB + (size_t)NTOK * DM * 2;
constexpr size_t WS_OMLB = WS_ROPE + 4096;
constexpr size_t WS_SCR = WS_ROPE + 16384;
constexpr size_t SZ_Y = (size_t)Q_ROWS * ODC * 2;
constexpr size_t SZ_ST = (size_t)256 * 16 * 16384 * 2;
constexpr size_t SZ_DEC = (size_t)256 * 16 * 128 * 4;
constexpr size_t SZ_NV = (size_t)256 * 8 * 128 * 4;
constexpr size_t WS_Y = WS_SCR, WS_ST = WS_Y + SZ_Y, WS_DEC = WS_ST + SZ_ST, WS_NV = WS_DEC + SZ_DEC, WS_END = WS_NV + SZ_NV;
constexpr size_t WS_STATS = WS_END;
constexpr size_t WS_ACT = WS_SCR;

struct Params {
    const float* in[19];
    float* X;
    unsigned char* ws;
};

__device__ __forceinline__ float bf2f(u16 b) { return __uint_as_float(((unsigned)b) << 16); }
__device__ __forceinline__ u16 f2bf(float f) { unsigned u = __float_as_uint(f); u += 0x7FFFu + ((u >> 16) & 1u); return (u16)(u >> 16); }
typedef float f32x2c __attribute__((ext_vector_type(2)));
typedef __bf16 bf16x2c __attribute__((ext_vector_type(2)));
__device__ __forceinline__ unsigned pk2(float lo, float hi) { f32x2c v = {lo, hi}; bf16x2c r = __builtin_convertvector(v, bf16x2c); return __builtin_bit_cast(unsigned, r); }
__device__ __forceinline__ float sigmoidf_(float x) { return __builtin_amdgcn_rcpf(1.0f + __expf(-x)); }
__device__ __forceinline__ float siluf_(float x) { return x * __builtin_amdgcn_rcpf(1.0f + __expf(-x)); }
__device__ __forceinline__ float logsigf_(float x) { return fminf(x, 0.f) - log1pf(__expf(-fabsf(x))); }
__device__ __forceinline__ float expc(float x) { return __expf(fminf(x, 80.f)); }
__device__ __forceinline__ void load16(const u16* p, float* o) {
    const u32x4v a = *(const u32x4v*)p, b = *(const u32x4v*)(p + 8);
#pragma unroll
    for (int i = 0; i < 4; ++i) { o[2 * i] = __uint_as_float(a[i] << 16); o[2 * i + 1] = __uint_as_float(a[i] & 0xffff0000u);
                                  o[8 + 2 * i] = __uint_as_float(b[i] << 16); o[8 + 2 * i + 1] = __uint_as_float(b[i] & 0xffff0000u); }
}
__device__ __forceinline__ void store16(u16* p, const float* v) {
    u32x4v a, b;
#pragma unroll
    for (int i = 0; i < 4; ++i) { a[i] = pk2(v[2 * i], v[2 * i + 1]); b[i] = pk2(v[8 + 2 * i], v[8 + 2 * i + 1]); }
    *(u32x4v*)p = a; *(u32x4v*)(p + 8) = b;
}

struct EpiSwiGLU {
    static constexpr bool PERM = true, AFTER_DRAIN = false, HAS_INIT = false;
    u16* O; int ldc;
    __device__ __forceinline__ void operator()(const f32x4 (&acc)[2][2][4][2], const pg8::Unit& u, int wr, int wc, int fr, int fq) const {
        const int row0 = u.pm * 256 + wr * 64 + fr, col0 = u.pn * 128 + wc * 32 + 8 * fq;
#pragma unroll
        for (int ai = 0; ai < 2; ++ai)
#pragma unroll
            for (int m = 0; m < 4; ++m) {
                u16* dst = O + (size_t)(row0 + ai * 128 + m * 16) * ldc + col0;
                float v[8];
#pragma unroll
                for (int n = 0; n < 2; ++n)
#pragma unroll
                    for (int j = 0; j < 4; ++j) { const float g = acc[ai][0][m][n][j], uu = acc[ai][1][m][n][j]; v[4 * n + j] = siluf_(g) * uu; }
                u32x4v o; o[0] = pk2(v[0], v[1]); o[1] = pk2(v[2], v[3]); o[2] = pk2(v[4], v[5]); o[3] = pk2(v[6], v[7]);
                *(u32x4v*)dst = o;
            }
    }
};
struct EpiBf16 {
    static constexpr bool PERM = true, AFTER_DRAIN = false, HAS_INIT = false;
    u16* O; int ldc;
    __device__ __forceinline__ void operator()(const f32x4 (&acc)[2][2][4][2], const pg8::Unit& u, int wr, int wc, int fr, int fq) const {
        const int row0 = u.pm * 256 + wr * 64 + fr, col0 = u.pn * 256 + wc * 32 + 8 * fq;
#pragma unroll
        for (int ai = 0; ai < 2; ++ai)
#pragma unroll
            for (int m = 0; m < 4; ++m)
#pragma unroll
                for (int bj = 0; bj < 2; ++bj) {
                    u16* dst = O + (size_t)(row0 + ai * 128 + m * 16) * ldc + col0 + bj * 128;
                    const f32x4 a = acc[ai][bj][m][0], b = acc[ai][bj][m][1];
                    u32x4v o; o[0] = pk2(a[0], a[1]); o[1] = pk2(a[2], a[3]); o[2] = pk2(b[0], b[1]); o[3] = pk2(b[2], b[3]);
                    *(u32x4v*)dst = o;
                }
    }
};
struct EpiResid {
    static constexpr bool PERM = false, AFTER_DRAIN = false, HAS_INIT = true;
    float* X; const float* src; float scale; const float* stats; const float* g; const float* b; bool dry;
    __device__ __forceinline__ f32x4 init(const pg8::Unit& u, int wr, int wc, int fr, int fq, int ai, int bj, int m, int n) const {
        const size_t row = (size_t)(u.pm * 256 + wr * 64 + fr + ai * 128 + m * 16);
        const int col = u.pn * 256 + wc * 32 + 4 * fq + bj * 128 + n * 16;
        f32x4v old = *(const f32x4v*)(src + row * DM + col);
        if (stats) { const f32x2c st = *(const f32x2c*)(stats + 2 * row); const f32x4v gv = *(const f32x4v*)(g + col), bv = *(const f32x4v*)(b + col);
            old = (old - st[0]) * st[1] * gv + bv; }
        const float k = ALPHA_F / scale;
        f32x4 r; r[0] = old[0] * k; r[1] = old[1] * k; r[2] = old[2] * k; r[3] = old[3] * k;
        return r;
    }
    __device__ __forceinline__ void operator()(const f32x4 (&acc)[2][2][4][2], const pg8::Unit& u, int wr, int wc, int fr, int fq) const {
        if (dry) return;
        const int row0 = u.pm * 256 + wr * 64 + fr, col0 = u.pn * 256 + wc * 32 + 4 * fq;
#pragma unroll
        for (int ai = 0; ai < 2; ++ai)
#pragma unroll
            for (int m = 0; m < 4; ++m) {
                float* rowp = X + (size_t)(row0 + ai * 128 + m * 16) * DM + col0;
#pragma unroll
                for (int bj = 0; bj < 2; ++bj)
#pragma unroll
                    for (int n = 0; n < 2; ++n) {
                        const f32x4 a = acc[ai][bj][m][n];
                        f32x4v r; r[0] = scale * a[0]; r[1] = scale * a[1]; r[2] = scale * a[2]; r[3] = scale * a[3];
                        *(f32x4v*)(rowp + bj * 128 + n * 16) = r;
                    }
            }
    }
};

template <class Epi>
__device__ __forceinline__ void run_gemm(unsigned char* shm, const u16* A, const u16* Bt, int M, int N, int K, const Epi& E) {
    pg8::Gemm g; g.A = A; g.Bt = Bt; g.M = M; g.N = N; g.K = K;
    pg8::StaticOrder S; S.init(M, N, (int)gridDim.x, obid());
    pg8::gemm_phase<Epi, pg8::StaticOrder, false>((PG8_LAS unsigned char*)shm, g, S, E, nullptr);
    __syncthreads();
}

__device__ __forceinline__ void transpose_tile(unsigned char* shm, const float* src, int K, int Nsrc, u16* dst, int r0, int n0, int k0) {
    float* tile = (float*)shm;
    const int tid = otid();
    {
        const int r = tid >> 4, c4 = (tid & 15) * 4;
#pragma unroll
        for (int i = 0; i < 2; ++i) {
            const int k = r + 32 * i;
            f32x4v v = {0.f, 0.f, 0.f, 0.f};
            if (n0 + c4 < Nsrc) v = *(const f32x4v*)(src + (size_t)(k0 + k) * Nsrc + n0 + c4);
            tile[k * 65 + c4 + 0] = v[0]; tile[k * 65 + c4 + 1] = v[1]; tile[k * 65 + c4 + 2] = v[2]; tile[k * 65 + c4 + 3] = v[3];
        }
    }
    __syncthreads();
    {
        const int n = tid >> 3, kg = (tid & 7) * 8;
        float v[8];
#pragma unroll
        for (int j = 0; j < 8; ++j) v[j] = tile[(kg + j) * 65 + n];
        u32x4v o; o[0] = pk2(v[0], v[1]); o[1] = pk2(v[2], v[3]); o[2] = pk2(v[4], v[5]); o[3] = pk2(v[6], v[7]);
        *(u32x4v*)(dst + (size_t)(r0 + n) * K + k0 + kg) = o;
    }
    __syncthreads();
}

__device__ void phase_prep(const Params& p, unsigned char* shm) {
    const int tid = otid();
    u16* XB = (u16*)(p.ws + WS_XB);
    {
        const size_t n4 = (size_t)NTOK * DM / 4, half4 = n4 / 2;
        for (size_t i = (size_t)blockIdx.x * 512 + tid; i < n4; i += (size_t)gridDim.x * 512) {
            const f32x4v v = (i < half4) ? ((const f32x4v*)p.in[0])[i] : ((const f32x4v*)p.in[1])[i - half4];
            u32x2v o; o[0] = pk2(v[0], v[1]); o[1] = pk2(v[2], v[3]);
            ((u32x2v*)XB)[i] = o;
        }
    }
    if (blockIdx.x == 0 && tid < 64) {
        double* rope = (double*)(p.ws + WS_ROPE);
        rope[tid] = exp2(-(double)tid / 64.0 * 13.287712379549449) / 6.283185307179586;
    }
    if (blockIdx.x == 1) {
        float* om = (float*)(p.ws + WS_OMLB);
        for (int i = tid; i < 2048; i += 512) {
            const int jj = i >> 10, rest = i & 1023;
            float lb = 0.f;
            if (jj > 0) lb = sigmoidf_(p.in[16][1024 + rest] - p.in[16][rest]);
            om[i] = 1.0f - lb;
        }
    }
    const int T_FI = 88 * 16, T_FO = 16 * 44, T_EI = 60 * 16, T_OI = 72 * 16, T_SQ = 16 * 16;
    const int total = 8 * T_FI + 8 * T_FO + 2 * T_EI + 2 * T_OI + 4 * T_SQ;
    for (int u = blockIdx.x; u < total; u += gridDim.x) {
        int r = u;
        if (r < 8 * T_FI) {
            const int mi = r / T_FI, ti = r % T_FI, which = mi >> 2, l = mi & 3;
            const float* src = p.in[which ? 4 : 2] + (size_t)l * 1024 * 5632;
            u16* dst = (u16*)(p.ws + WS_FFN_IN + (size_t)mi * SZ_FFN_IN);
            const int rt = ti >> 4, kt = ti & 15;
            const int r0 = rt * 64, pn = r0 >> 8, hh = (r0 >> 7) & 1, jj = (r0 >> 6) & 1;
            transpose_tile(shm, src, 1024, 5632, dst, r0, hh * 2816 + pn * 128 + jj * 64, kt * 64);
            continue;
        }
        r -= 8 * T_FI;
        if (r < 8 * T_FO) {
            const int mi = r / T_FO, ti = r % T_FO, which = mi >> 2, l = mi & 3;
            const float* src = p.in[which ? 5 : 3] + (size_t)l * 2816 * 1024;
            u16* dst = (u16*)(p.ws + WS_FFN_OUT + (size_t)mi * SZ_FFN_OUT);
            const int rt = ti / 44, kt = ti % 44;
            transpose_tile(shm, src, 2816, 1024, dst, rt * 64, rt * 64, kt * 64);
            continue;
        }
        r -= 8 * T_FO;
        if (r < 2 * T_EI) {
            const int j = r / T_EI, ti = r % T_EI;
            const float* src = p.in[8] + (size_t)j * 1024 * 3632;
            u16* dst = (u16*)(p.ws + WS_EV_IN + (size_t)j * SZ_EV_IN);
            const int rt = ti >> 4, kt = ti & 15;
            transpose_tile(shm, src, 1024, 3632, dst, rt * 64, rt * 64, kt * 64);
            continue;
        }
        r -= 2 * T_EI;
        if (r < 2 * T_OI) {
            const int j = r / T_OI, ti = r % T_OI;
            const float* src = p.in[15] + (size_t)j * 1024 * 4608;
            u16* dst = (u16*)(p.ws + WS_OD_IN + (size_t)j * SZ_OD_IN);
            const int rt = ti >> 4, kt = ti & 15;
            transpose_tile(shm, src, 1024, 4608, dst, rt * 64, rt * 64, kt * 64);
            continue;
        }
        r -= 2 * T_OI;
        {
            const int mi = r / T_SQ, ti = r % T_SQ;
            const float* src = p.in[mi < 2 ? 14 : 18] + (size_t)(mi & 1) * 1024 * 1024;
            u16* dst = (u16*)(p.ws + (mi < 2 ? WS_EV_OUT : WS_OD_OUT) + (size_t)(mi & 1) * SZ_SQ);
            const int rt = ti >> 4, kt = ti & 15;
            transpose_tile(shm, src, 1024, 1024, dst, rt * 64, rt * 64, kt * 64);
        }
    }
}

__device__ void phase_ln(const Params& p, const float* g, const float* b, bool write_x) {
    const int tid = otid(); const int lane = tid & 63, w = tid >> 6;
    u16* XB = (u16*)(p.ws + WS_XB); float* STATS = (float*)(p.ws + WS_STATS);
    f32x4v gv[4], bv[4];
#pragma unroll
    for (int i = 0; i < 4; ++i) { gv[i] = *(const f32x4v*)(g + 4 * lane + 256 * i); bv[i] = *(const f32x4v*)(b + 4 * lane + 256 * i); }
    for (int row = blockIdx.x * 8 + w; row < NTOK; row += gridDim.x * 8) {
        float* xr = p.X + (size_t)row * DM;
        f32x4v v[4];
#pragma unroll
        for (int i = 0; i < 4; ++i) v[i] = *(const f32x4v*)(xr + 4 * lane + 256 * i);
        float s = 0.f;
#pragma unroll
        for (int i = 0; i < 4; ++i) s += v[i][0] + v[i][1] + v[i][2] + v[i][3];
#pragma unroll
        for (int o = 32; o >= 1; o >>= 1) s += __shfl_xor(s, o);
        const float mu = s * (1.0f / 1024.0f);
        float q = 0.f;
#pragma unroll
        for (int i = 0; i < 4; ++i)
#pragma unroll
            for (int j = 0; j < 4; ++j) { const float d = v[i][j] - mu; q += d * d; }
#pragma unroll
        for (int o = 32; o >= 1; o >>= 1) q += __shfl_xor(q, o);
        const float rs = rsqrtf(q * (1.0f / 1024.0f) + 1e-5f);
        if (lane == 0) { f32x2c st; st[0] = mu; st[1] = rs; *(f32x2c*)(STATS + 2 * (size_t)row) = st; }
#pragma unroll
        for (int i = 0; i < 4; ++i) {
            f32x4v o4;
#pragma unroll
            for (int j = 0; j < 4; ++j) o4[j] = (v[i][j] - mu) * rs * gv[i][j] + bv[i][j];
            if (write_x) *(f32x4v*)(xr + 4 * lane + 256 * i) = o4;
            u32x2v o2; o2[0] = pk2(o4[0], o4[1]); o2[1] = pk2(o4[2], o4[3]);
            *(u32x2v*)(XB + (size_t)row * DM + 4 * lane + 256 * i) = o2;
        }
    }
}

constexpr int QS = 136, VTS = 72, BS = 132, PS = 72;
constexpr int OFF_QN = 0;
constexpr int OFF_KN = OFF_QN + 64 * QS * 2;
constexpr int OFF_VT = OFF_KN + 64 * QS * 2;
constexpr int OFF_B = OFF_VT + 128 * VTS * 2;
constexpr int OFF_QS = OFF_B + 64 * BS * 4;
constexpr int OFF_KS = OFF_QS + 64 * QS * 2;
constexpr int OFF_QI = OFF_KS + 64 * QS * 2;
constexpr int OFF_P = OFF_QI + 64 * QS * 2;
constexpr int OFF_MISC = OFF_P + 64 * PS * 2;
constexpr int SCAN_LDS = OFF_MISC + 9216;
static_assert(SCAN_LDS <= 160 * 1024, "lds");
static_assert((OFF_B % 16) == 0 && (OFF_QS % 16) == 0 && (OFF_P % 16) == 0 && (OFF_MISC % 16) == 0, "align");

struct ScanCtx {
    const u16* Y; int ld;
    u16* H;
    u16* ST; float* DEC; float* NV;
    int cps;
    int even;
    int j;
    const float *gate_b, *conv_w, *a2_w, *a2_b, *norm_w, *lb_logits;
    const double* rope; const float* omlb;
};

__device__ __forceinline__ void unpack16(const u32x4v a, const u32x4v b, float* o) {
#pragma unroll
    for (int i = 0; i < 4; ++i) { o[2 * i] = __uint_as_float(a[i] << 16); o[2 * i + 1] = __uint_as_float(a[i] & 0xffff0000u);
                                  o[8 + 2 * i] = __uint_as_float(b[i] << 16); o[8 + 2 * i + 1] = __uint_as_float(b[i] & 0xffff0000u); }
}
__device__ __forceinline__ void put_v(u16* Vn, int t, int d0, const u32x4v a, const u32x4v b) {
    *(u32x4v*)(Vn + t * QS + d0) = a; *(u32x4v*)(Vn + t * QS + d0 + 8) = b;
}
template <int MODE, int MIX>
__device__ void scan_unit(const ScanCtx& cx, int c, int h, unsigned char* lds) {
    constexpr int dk = (MIX == 1) ? 64 : 128;
    constexpr bool scalar = (MIX == 0 || MIX == 3);
    constexpr int NKK = dk / 32;
    const int head = (MIX & 1) * 4 + h;
    const int tid = otid(), lane = tid & 63, w = tid >> 6;
    u16* Qn = (u16*)(lds + OFF_QN); u16* Kn = (u16*)(lds + OFF_KN); u16* VT = (u16*)(lds + OFF_VT); u16* Vg = (u16*)(lds + OFF_QI);
    float* Bm = (float*)(lds + OFF_B);
    u16* Qs = (u16*)(lds + OFF_QS); u16* Ks = (u16*)(lds + OFF_KS); u16* Qi = (u16*)(lds + OFF_QI); u16* Pm = (u16*)(lds + OFF_P);
    u16* Pb = Qs;
    float* GT = (float*)(lds + OFF_MISC);
    float* NPREV = GT + 256;
    float* DEN = NPREV + 256;
    float* SEG = DEN + 128;
    float* BFB = SEG + 512;
    const int t = tid >> 3, g = tid & 7, d0 = g * 16;
    const int cs = c % cx.cps;
    const size_t row0 = (size_t)c * 64;
    const int ld = cx.ld;
    const u16* Yr = cx.Y + (row0 + t) * ld;
    const int lr = lane & 15, lq = lane >> 4;
    const float lgam = log1pf(-exp2f(-5.0f - (float)h));

    u32x4v rk[5][2], rq[5][2], rv[2], rg[2], rz[2][2], rba[4];
    float gr[4] = {0.f, 0.f, 0.f, 0.f}, nvp[2] = {0.f, 0.f};
    bf16x8 sb[2][NKK];
    if constexpr (MIX == 0) {
#pragma unroll
        for (int jt = 0; jt < 5; ++jt) {
            const int tt = cs * 64 + t + jt - 2;
            const bool ok = (tt >= 0 && tt < cx.cps * 64);
            const u16* src = cx.Y + (row0 + t + (ok ? jt - 2 : 0)) * ld + h * 128 + d0;
            rk[jt][0] = *(const u32x4v*)(src + 512); rk[jt][1] = *(const u32x4v*)(src + 512 + 8);
            if (!ok) { rk[jt][0] = (u32x4v){0u, 0u, 0u, 0u}; rk[jt][1] = (u32x4v){0u, 0u, 0u, 0u}; }
        }
        rv[0] = *(const u32x4v*)(Yr + 1024 + h * 128 + d0); rv[1] = *(const u32x4v*)(Yr + 1024 + h * 128 + d0 + 8);
        if (tid < 64) { const u16* yr = cx.Y + (row0 + tid) * ld + 2048;
#pragma unroll
            for (int i = 0; i < 4; ++i) gr[i] = bf2f(yr[4 * i + h]); }
        if (MODE == 1) { rg[0] = *(const u32x4v*)(Yr + 1536 + h * 128 + d0); rg[1] = *(const u32x4v*)(Yr + 1536 + h * 128 + d0 + 8);
            if (tid < 128) { nvp[0] = cx.NV[((size_t)c * 8 + h * 2 + 0) * 128 + tid]; nvp[1] = cx.NV[((size_t)c * 8 + h * 2 + 1) * 128 + tid]; } }
    } else if constexpr (MIX == 1) {
        if (g < 4) { if (MODE == 1) { rq[0][0] = *(const u32x4v*)(Yr + 2064 + h * 64 + d0); rq[0][1] = *(const u32x4v*)(Yr + 2064 + h * 64 + d0 + 8); } }
        else { rk[0][0] = *(const u32x4v*)(Yr + 2320 + h * 64 + d0 - 64); rk[0][1] = *(const u32x4v*)(Yr + 2320 + h * 64 + d0 - 64 + 8); }
        rv[0] = *(const u32x4v*)(Yr + 2576 + h * 128 + d0); rv[1] = *(const u32x4v*)(Yr + 2576 + h * 128 + d0 + 8);
#pragma unroll
        for (int i = 0; i < 4; ++i) rba[i] = *(const u32x4v*)(Yr + 3600 + 8 * i);
        if (MODE == 1) { rg[0] = *(const u32x4v*)(Yr + 3088 + h * 128 + d0); rg[1] = *(const u32x4v*)(Yr + 3088 + h * 128 + d0 + 8); }
    } else if constexpr (MIX == 2) {
        if (MODE == 1) { rq[0][0] = *(const u32x4v*)(Yr + h * 128 + d0); rq[0][1] = *(const u32x4v*)(Yr + h * 128 + d0 + 8); }
        rv[0] = *(const u32x4v*)(Yr + 1536 + h * 128 + d0); rv[1] = *(const u32x4v*)(Yr + 1536 + h * 128 + d0 + 8);
#pragma unroll
        for (int dd = 0; dd < 2; ++dd) { rz[dd][0] = *(const u32x4v*)(Yr + 512 + dd * 512 + h * 128 + d0); rz[dd][1] = *(const u32x4v*)(Yr + 512 + dd * 512 + h * 128 + d0 + 8); }
        if (MODE == 1) { rg[0] = *(const u32x4v*)(Yr + 2048 + h * 128 + d0); rg[1] = *(const u32x4v*)(Yr + 2048 + h * 128 + d0 + 8); }
    } else {
        const int gg = g & 3, isk = g >> 2;
        if (MODE == 1 || isk) { const u16* src = Yr + (isk ? 3072 : 2560) + h * 128 + gg * 16;
            rq[0][0] = *(const u32x4v*)src; rq[0][1] = *(const u32x4v*)(src + 8); rq[1][0] = *(const u32x4v*)(src + 64); rq[1][1] = *(const u32x4v*)(src + 72); }
        rv[0] = *(const u32x4v*)(Yr + 3584 + h * 128 + d0); rv[1] = *(const u32x4v*)(Yr + 3584 + h * 128 + d0 + 8);
        if (MODE == 1) { rg[0] = *(const u32x4v*)(Yr + 4096 + h * 128 + d0); rg[1] = *(const u32x4v*)(Yr + 4096 + h * 128 + d0 + 8); }
    }
    if (MODE == 1) {
#pragma unroll
        for (int dd = 0; dd < 2; ++dd)
#pragma unroll
            for (int kk = 0; kk < NKK; ++kk) sb[dd][kk] = *(const bf16x8*)(cx.ST + ((size_t)c * 16 + head * 2 + dd) * 16384 + (16 * w + lr) * 128 + 32 * kk + 8 * lq);
    }

    if constexpr (MIX == 0) {
#pragma unroll 1
        for (int which = 1; which >= (MODE == 0 ? 1 : 0); --which) {
            const int ch0 = which * 512 + h * 128 + d0;
            if (which == 0) {
#pragma unroll
                for (int jt = 0; jt < 5; ++jt) {
                    const int tt = cs * 64 + t + jt - 2;
                    const bool ok = (tt >= 0 && tt < cx.cps * 64);
                    const u16* src = cx.Y + (row0 + t + (ok ? jt - 2 : 0)) * ld + h * 128 + d0;
                    rk[jt][0] = *(const u32x4v*)src; rk[jt][1] = *(const u32x4v*)(src + 8);
                    if (!ok) { rk[jt][0] = (u32x4v){0u, 0u, 0u, 0u}; rk[jt][1] = (u32x4v){0u, 0u, 0u, 0u}; }
                }
            }
            float acc[16];
#pragma unroll
            for (int i = 0; i < 16; ++i) acc[i] = 0.f;
#pragma unroll
            for (int jt = 0; jt < 5; ++jt) {
                float xv[16];
                unpack16(rk[jt][0], rk[jt][1], xv);
                const f32x4v* wj = (const f32x4v*)(cx.conv_w + jt * 1024 + ch0);
#pragma unroll
                for (int q4 = 0; q4 < 4; ++q4) { const f32x4v wv = wj[q4];
#pragma unroll
                    for (int jx = 0; jx < 4; ++jx) acc[4 * q4 + jx] += xv[4 * q4 + jx] * wv[jx]; }
            }
            const float sc = which ? 0.08838834764831845f : 1.0f;
#pragma unroll
            for (int i = 0; i < 16; ++i) acc[i] = acc[i] * sc * __builtin_amdgcn_rcpf(1.0f + __expf(-acc[i]));
            store16((which ? Kn : Qn) + t * QS + d0, acc);
        }
        put_v(Vg, t, d0, rv[0], rv[1]);
        if (tid < 64) {
            GT[0 * 64 + tid] = gr[0] + cx.gate_b[0 + h]; GT[1 * 64 + tid] = logsigf_(gr[1] + cx.gate_b[4 + h]);
            GT[2 * 64 + tid] = gr[2] + cx.gate_b[8 + h]; GT[3 * 64 + tid] = logsigf_(gr[3] + cx.gate_b[12 + h]);
        }
        if (MODE == 1 && tid < 128) { NPREV[tid] = nvp[0]; NPREV[128 + tid] = nvp[1]; }
    } else if constexpr (MIX == 1) {
        if (g < 4) {
            if (MODE == 1) { float xv[16]; unpack16(rq[0][0], rq[0][1], xv);
#pragma unroll
                for (int i = 0; i < 16; ++i) xv[i] *= 0.125f;
                store16(Qn + t * QS + d0, xv); }
        } else { *(u32x4v*)(Kn + t * QS + (d0 - 64)) = rk[0][0]; *(u32x4v*)(Kn + t * QS + (d0 - 64) + 8) = rk[0][1]; }
        put_v(Vg, t, d0, rv[0], rv[1]);
    } else if constexpr (MIX == 2) {
        if (MODE == 1) { float xv[16]; unpack16(rq[0][0], rq[0][1], xv);
#pragma unroll
            for (int i = 0; i < 16; ++i) xv[i] = xv[i] * 0.08838834764831845f * __builtin_amdgcn_rcpf(1.0f + __expf(-xv[i]));
            store16(Qn + t * QS + d0, xv); }
        put_v(Vg, t, d0, rv[0], rv[1]);
    } else {
        const int gg = g & 3, isk = g >> 2;
        if (MODE == 1 || isk) {
            float x1[16], x2[16], o1[16], o2[16];
            unpack16(rq[0][0], rq[0][1], x1); unpack16(rq[1][0], rq[1][1], x2);
            const double pos = (double)(cs * 64 + t);
            const float sc = isk ? 0.08838834764831845f : 1.0f;
#pragma unroll
            for (int i = 0; i < 16; ++i) {
                const double tr = pos * cx.rope[gg * 16 + i];
                const float fr = (float)(tr - rint(tr));
                const float sn = __builtin_amdgcn_sinf(fr) * sc, cn = __builtin_amdgcn_cosf(fr) * sc;
                o1[i] = x1[i] * cn - x2[i] * sn; o2[i] = x1[i] * sn + x2[i] * cn;
            }
            u16* dstp = (isk ? Kn : Qn) + t * QS;
            store16(dstp + gg * 16, o1); store16(dstp + 64 + gg * 16, o2);
        }
        put_v(Vg, t, d0, rv[0], rv[1]);
    }
    __syncthreads();
    {
        const u32x4v a = *(const u32x4v*)(Vg + lane * QS + 16 * w), b = *(const u32x4v*)(Vg + lane * QS + 16 * w + 8);
#pragma unroll
        for (int i = 0; i < 4; ++i) {
            VT[(16 * w + 2 * i) * VTS + lane] = (u16)(a[i] & 0xffffu); VT[(16 * w + 2 * i + 1) * VTS + lane] = (u16)(a[i] >> 16);
            VT[(16 * w + 8 + 2 * i) * VTS + lane] = (u16)(b[i] & 0xffffu); VT[(16 * w + 8 + 2 * i + 1) * VTS + lane] = (u16)(b[i] >> 16);
        }
    }

    f32x4 acc_tot[4];
#pragma unroll
    for (int i = 0; i < 4; ++i) acc_tot[i] = (f32x4){0.f, 0.f, 0.f, 0.f};

    if constexpr (scalar && MODE == 1) {
        if constexpr (MIX == 0) {
            if (w < 2) {
                float v = GT[(1 + 2 * w) * 64 + lane];
                if (w == 0) {
#pragma unroll
                    for (int o = 1; o < 64; o <<= 1) { const float n = __shfl_up(v, o); if (lane >= o) v += n; }
                } else {
#pragma unroll
                    for (int o = 1; o < 64; o <<= 1) { const float n = __shfl_down(v, o); if (lane + o < 64) v += n; }
                }
                BFB[w * 64 + lane] = v;
            }
        } else {
            if (tid < 128) { const int dd = tid >> 6, tt = tid & 63; BFB[tid] = lgam * (float)(dd ? (64 - tt) : (tt + 1)); }
        }
        __syncthreads();
        {
            const int ti = w >> 1, tj0 = 2 * (w & 1);
            f32x4 sc[2] = {(f32x4){0.f, 0.f, 0.f, 0.f}, (f32x4){0.f, 0.f, 0.f, 0.f}};
#pragma unroll
            for (int kk = 0; kk < NKK; ++kk) {
                const bf16x8 af = *(const bf16x8*)(Qn + (16 * ti + lr) * QS + 32 * kk + 8 * lq);
#pragma unroll
                for (int jj = 0; jj < 2; ++jj) {
                    const bf16x8 bfr = *(const bf16x8*)(Kn + (16 * (tj0 + jj) + lr) * QS + 32 * kk + 8 * lq);
                    sc[jj] = __builtin_amdgcn_mfma_f32_16x16x32_bf16(af, bfr, sc[jj], 0, 0, 0);
                }
            }
#pragma unroll
            for (int dd = 0; dd < 2; ++dd) {
                u16* Pd = dd ? Pb : Pm;
#pragma unroll
                for (int jj = 0; jj < 2; ++jj) {
                    const int ss = 16 * (tj0 + jj) + lr;
                    const float bs = BFB[dd * 64 + ss] - ((MIX == 0) ? GT[(2 * dd) * 64 + ss] : 0.f);
#pragma unroll
                    for (int r = 0; r < 4; ++r) {
                        const int tt = 16 * ti + 4 * lq + r;
                        const bool keep = dd ? (ss >= tt) : (ss <= tt);
                        const float wgt = __expf(fminf(BFB[dd * 64 + tt] - bs, 60.f));
                        Pd[tt * PS + ss] = (u16)(pk2(keep ? sc[jj][r] * wgt : 0.f, 0.f) & 0xffffu);
                    }
                }
            }
        }
        __syncthreads();
        if constexpr (MIX == 0) {
            float pf[16], pbv[16], qv[16];
            const u32x4v p0 = *(const u32x4v*)(Pm + t * PS + 8 * g), p1 = *(const u32x4v*)(Pb + t * PS + 8 * g);
            unpack16(p0, p0, pf); unpack16(p1, p1, pbv);
            unpack16(*(const u32x4v*)(Qn + t * QS + d0), *(const u32x4v*)(Qn + t * QS + d0 + 8), qv);
            float vf = 0.f, vb2 = 0.f, qf = 0.f, qb = 0.f;
#pragma unroll
            for (int i = 0; i < 8; ++i) { vf += pf[i]; vb2 += pbv[i]; }
#pragma unroll
            for (int i = 0; i < 16; ++i) { qf += qv[i] * NPREV[d0 + i]; qb += qv[i] * NPREV[128 + d0 + i]; }
            vf += __expf(BFB[t]) * qf; vb2 += __expf(BFB[64 + t]) * qb;
            vf += __shfl_xor(vf, 1); vb2 += __shfl_xor(vb2, 1); vf += __shfl_xor(vf, 2); vb2 += __shfl_xor(vb2, 2); vf += __shfl_xor(vf, 4); vb2 += __shfl_xor(vb2, 4);
            if (g == 0) { DEN[t] = vf; DEN[64 + t] = vb2; }
            __syncthreads();
        }
#pragma unroll
        for (int dd = 0; dd < 2; ++dd) {
            const u16* Pd = dd ? Pb : Pm;
            f32x4 ad[4], ai[4];
#pragma unroll
            for (int i = 0; i < 4; ++i) { ad[i] = (f32x4){0.f, 0.f, 0.f, 0.f}; ai[i] = (f32x4){0.f, 0.f, 0.f, 0.f}; }
#pragma unroll
            for (int kk = 0; kk < 2; ++kk) {
                const bf16x8 vb = *(const bf16x8*)(VT + (16 * w + lr) * VTS + 32 * kk + 8 * lq);
#pragma unroll
                for (int ti = 0; ti < 4; ++ti) {
                    const bf16x8 af = *(const bf16x8*)(Pd + (16 * ti + lr) * PS + 32 * kk + 8 * lq);
                    ad[ti] = __builtin_amdgcn_mfma_f32_16x16x32_bf16(af, vb, ad[ti], 0, 0, 0);
                }
            }
#pragma unroll
            for (int kk = 0; kk < NKK; ++kk)
#pragma unroll
                for (int ti = 0; ti < 4; ++ti) {
                    const bf16x8 af = *(const bf16x8*)(Qn + (16 * ti + lr) * QS + 32 * kk + 8 * lq);
                    ai[ti] = __builtin_amdgcn_mfma_f32_16x16x32_bf16(af, sb[dd][kk], ai[ti], 0, 0, 0);
                }
#pragma unroll
            for (int ti = 0; ti < 4; ++ti)
#pragma unroll
                for (int r = 0; r < 4; ++r) {
                    const int tt = 16 * ti + 4 * lq + r;
                    float v = ad[ti][r] + __expf(BFB[dd * 64 + tt]) * ai[ti][r];
                    if (MIX == 0) v *= __builtin_amdgcn_rcpf(fmaxf(fabsf(DEN[dd * 64 + tt]), 1.0f));
                    acc_tot[ti][r] += v;
                }
        }
        __syncthreads();
    } else {
#pragma unroll 1
    for (int dir = 0; dir < 2; ++dir) {
        if constexpr (MIX == 1) {
            const int dd0 = g * 8;
            float ba[16];
            if (dir == 0) unpack16(rba[0], rba[1], ba); else unpack16(rba[2], rba[3], ba);
            const float* w2 = cx.a2_w + (size_t)dir * 16 * 256 + h * 64 + dd0;
            const float* b2 = cx.a2_b + dir * 256 + h * 64 + dd0;
            f32x4v a0 = *(const f32x4v*)b2, a1 = *(const f32x4v*)(b2 + 4);
#pragma unroll
            for (int r = 0; r < 16; ++r) { const f32x4v w0 = *(const f32x4v*)(w2 + r * 256), w1 = *(const f32x4v*)(w2 + r * 256 + 4); a0 += ba[r] * w0; a1 += ba[r] * w1; }
            f32x4v o0, o1;
#pragma unroll
            for (int i = 0; i < 4; ++i) { o0[i] = logsigf_(a0[i]) * 0.0625f; o1[i] = logsigf_(a1[i]) * 0.0625f; }
            *(f32x4v*)(Bm + t * BS + dd0) = o0; *(f32x4v*)(Bm + t * BS + dd0 + 4) = o1;
        } else if constexpr (MIX == 2) {
            float z[16], kk[16];
            if (dir == 0) unpack16(rz[0][0], rz[0][1], z); else unpack16(rz[1][0], rz[1][1], z);
            const f32x4v* om = (const f32x4v*)(cx.omlb + (cx.j * 2 + dir) * 512 + h * 128 + d0);
#pragma unroll
            for (int q4 = 0; q4 < 4; ++q4) {
                const f32x4v ov = om[q4]; f32x4v lo;
#pragma unroll
                for (int jx = 0; jx < 4; ++jx) {
                    const float E = __expf(fminf(-z[4 * q4 + jx], 80.f)), r = __builtin_amdgcn_rcpf(1.0f + E), ol = ov[jx];
                    lo[jx] = __logf(fmaxf((1.0f - ol) + ol * r, 1e-30f));
                    kk[4 * q4 + jx] = ol * E * r;
                }
                *(f32x4v*)(Bm + t * BS + d0 + 4 * q4) = lo;
            }
            store16(Kn + t * QS + d0, kk);
        }
        if constexpr (!scalar) __syncthreads();
        if constexpr (scalar) {
            if (w == 0) {
                float v = (MIX == 0) ? GT[(1 + 2 * dir) * 64 + lane] : lgam;
                if (dir == 0) {
#pragma unroll
                    for (int o = 1; o < 64; o <<= 1) { const float n = __shfl_up(v, o); if (lane >= o) v += n; }
                } else {
#pragma unroll
                    for (int o = 1; o < 64; o <<= 1) { const float n = __shfl_down(v, o); if (lane + o < 64) v += n; }
                }
                Bm[lane * BS] = v;
            }
        } else {
            const int d = tid & 127, sg = tid >> 7;
            if (d < dk) {
                float run = 0.f;
                if (dir == 0) {
#pragma unroll
                    for (int i = 0; i < 16; ++i) { const int tt = sg * 16 + i; run += Bm[tt * BS + d]; Bm[tt * BS + d] = run; } }
                else {
#pragma unroll
                    for (int i = 15; i >= 0; --i) { const int tt = sg * 16 + i; run += Bm[tt * BS + d]; Bm[tt * BS + d] = run; } }
                SEG[sg * 128 + d] = run;
            }
            __syncthreads();
            if (d < dk) {
                float off = 0.f;
                if (dir == 0) { for (int s2 = 0; s2 < sg; ++s2) off += SEG[s2 * 128 + d]; }
                else { for (int s2 = 3; s2 > sg; --s2) off += SEG[s2 * 128 + d]; }
#pragma unroll
                for (int i = 0; i < 16; ++i) Bm[(sg * 16 + i) * BS + d] += off;
            }
        }
        __syncthreads();

        const int tend = dir ? 0 : 63;
        const size_t slot = (size_t)c * 16 + head * 2 + dir;
        const float li = (MIX == 0) ? GT[(2 * dir) * 64 + t] : 0.f;
        if (MODE == 0) {
            u16* KT = Qs;
            if (16 * w < dk) {
                float kv[16]; unpack16(*(const u32x4v*)(Kn + lane * QS + 16 * w), *(const u32x4v*)(Kn + lane * QS + 16 * w + 8), kv);
                const float lis = (MIX == 0) ? GT[(2 * dir) * 64 + lane] : 0.f;
                if (scalar) {
                    const float e = expc(Bm[tend * BS] - Bm[lane * BS] + lis);
#pragma unroll
                    for (int i = 0; i < 16; ++i) kv[i] *= e;
                } else {
#pragma unroll
                    for (int q4 = 0; q4 < 4; ++q4) { const f32x4v be = *(const f32x4v*)(Bm + tend * BS + 16 * w + 4 * q4), bt = *(const f32x4v*)(Bm + lane * BS + 16 * w + 4 * q4);
#pragma unroll
                        for (int jx = 0; jx < 4; ++jx) kv[4 * q4 + jx] *= expc(be[jx] - bt[jx]); }
                }
#pragma unroll
                for (int i = 0; i < 8; ++i) { const unsigned pkd = pk2(kv[2 * i], kv[2 * i + 1]);
                    KT[(16 * w + 2 * i) * VTS + lane] = (u16)(pkd & 0xffffu); KT[(16 * w + 2 * i + 1) * VTS + lane] = (u16)(pkd >> 16); }
            }
            if (tid < 128) cx.DEC[slot * 128 + tid] = __expf(Bm[tend * BS + (scalar ? 0 : (tid < dk ? tid : 0))]);
            __syncthreads();
            if (MIX == 0 && tid < 128) {
                float s = 0.f;
#pragma unroll
                for (int q8 = 0; q8 < 8; ++q8) { float xv[16]; const u32x4v r = *(const u32x4v*)(KT + tid * VTS + 8 * q8); unpack16(r, r, xv);
#pragma unroll
                    for (int i = 0; i < 8; ++i) s += xv[i]; }
                cx.NV[((size_t)c * 8 + h * 2 + dir) * 128 + tid] = s;
            }
            bf16x8 vb[2];
#pragma unroll
            for (int kk = 0; kk < 2; ++kk) vb[kk] = *(const bf16x8*)(VT + (16 * w + lr) * VTS + 32 * kk + 8 * lq);
            u16* Sd = cx.ST + slot * 16384;
#pragma unroll 2
            for (int di = 0; di < dk / 16; ++di) {
                f32x4 a4 = (f32x4){0.f, 0.f, 0.f, 0.f};
#pragma unroll
                for (int kk = 0; kk < 2; ++kk) {
                    const bf16x8 af = *(const bf16x8*)(KT + (16 * di + lr) * VTS + 32 * kk + 8 * lq);
                    a4 = __builtin_amdgcn_mfma_f32_16x16x32_bf16(af, vb[kk], a4, 0, 0, 0);
                }
                u32x2v o; o[0] = pk2(a4[0], a4[1]); o[1] = pk2(a4[2], a4[3]);
                *(u32x2v*)(Sd + (16 * w + lr) * 128 + 16 * di + 4 * lq) = o;
            }
            __syncthreads();
        } else {
            const int tmid = 32;
            if (d0 < dk) {
                float qv[16], kv[16], a[16], bb[16], cc[16];
                unpack16(*(const u32x4v*)(Qn + t * QS + d0), *(const u32x4v*)(Qn + t * QS + d0 + 8), qv);
                unpack16(*(const u32x4v*)(Kn + t * QS + d0), *(const u32x4v*)(Kn + t * QS + d0 + 8), kv);
#pragma unroll
                for (int q4 = 0; q4 < 4; ++q4) { const f32x4v bmv = *(const f32x4v*)(Bm + tmid * BS + d0 + 4 * q4), bt = *(const f32x4v*)(Bm + t * BS + d0 + 4 * q4);
#pragma unroll
                    for (int jx = 0; jx < 4; ++jx) { const int i = 4 * q4 + jx; const float df = bt[jx] - bmv[jx];
                        a[i] = qv[i] * expc(df); bb[i] = kv[i] * expc(-df); cc[i] = qv[i] * __expf(bt[jx]); } }
                store16(Qs + t * QS + d0, a); store16(Ks + t * QS + d0, bb); store16(Qi + t * QS + d0, cc);
            }
            __syncthreads();
            {
                const int ti = w >> 1, tj0 = 2 * (w & 1);
                f32x4 sc[2] = {(f32x4){0.f, 0.f, 0.f, 0.f}, (f32x4){0.f, 0.f, 0.f, 0.f}};
#pragma unroll
                for (int kk = 0; kk < NKK; ++kk) {
                    const bf16x8 af = *(const bf16x8*)(Qs + (16 * ti + lr) * QS + 32 * kk + 8 * lq);
#pragma unroll
                    for (int jj = 0; jj < 2; ++jj) {
                        const bf16x8 bfr = *(const bf16x8*)(Ks + (16 * (tj0 + jj) + lr) * QS + 32 * kk + 8 * lq);
                        sc[jj] = __builtin_amdgcn_mfma_f32_16x16x32_bf16(af, bfr, sc[jj], 0, 0, 0);
                    }
                }
#pragma unroll
                for (int jj = 0; jj < 2; ++jj)
#pragma unroll
                    for (int r = 0; r < 4; ++r) {
                        const int tt = 16 * ti + 4 * lq + r, ss = 16 * (tj0 + jj) + lr;
                        const bool keep = dir ? (ss >= tt) : (ss <= tt);
                        Pm[tt * PS + ss] = (u16)(pk2(keep ? sc[jj][r] : 0.f, 0.f) & 0xffffu);
                    }
            }
            __syncthreads();
            f32x4 ad[4];
#pragma unroll
            for (int i = 0; i < 4; ++i) ad[i] = (f32x4){0.f, 0.f, 0.f, 0.f};
#pragma unroll
            for (int kk = 0; kk < 2; ++kk) {
                const bf16x8 vb = *(const bf16x8*)(VT + (16 * w + lr) * VTS + 32 * kk + 8 * lq);
#pragma unroll
                for (int ti = 0; ti < 4; ++ti) {
                    const bf16x8 af = *(const bf16x8*)(Pm + (16 * ti + lr) * PS + 32 * kk + 8 * lq);
                    ad[ti] = __builtin_amdgcn_mfma_f32_16x16x32_bf16(af, vb, ad[ti], 0, 0, 0);
                }
            }
#pragma unroll
            for (int kk = 0; kk < NKK; ++kk)
#pragma unroll
                for (int ti = 0; ti < 4; ++ti) {
                    const bf16x8 af = *(const bf16x8*)(Qi + (16 * ti + lr) * QS + 32 * kk + 8 * lq);
                    ad[ti] = __builtin_amdgcn_mfma_f32_16x16x32_bf16(af, dir ? sb[1][kk] : sb[0][kk], ad[ti], 0, 0, 0);
                }
#pragma unroll
            for (int ti = 0; ti < 4; ++ti) acc_tot[ti] += ad[ti];
            __syncthreads();
        }
    }
    }

    if (MODE == 1) {
        float* Ot = Bm;
#pragma unroll
        for (int ti = 0; ti < 4; ++ti)
#pragma unroll
            for (int r = 0; r < 4; ++r) Ot[(16 * ti + 4 * lq + r) * BS + 16 * w + lr] = acc_tot[ti][r];
        __syncthreads();
        float ov[16];
#pragma unroll
        for (int q4 = 0; q4 < 4; ++q4) { const f32x4v x = *(const f32x4v*)(Ot + t * BS + d0 + 4 * q4); ov[4 * q4] = x[0]; ov[4 * q4 + 1] = x[1]; ov[4 * q4 + 2] = x[2]; ov[4 * q4 + 3] = x[3]; }
        float s1 = 0.f, s2 = 0.f;
#pragma unroll
        for (int i = 0; i < 16; ++i) { s1 += ov[i]; s2 += ov[i] * ov[i]; }
        s1 += __shfl_xor(s1, 1); s2 += __shfl_xor(s2, 1); s1 += __shfl_xor(s1, 2); s2 += __shfl_xor(s2, 2); s1 += __shfl_xor(s1, 4); s2 += __shfl_xor(s2, 4);
        constexpr bool lnorm = (MIX == 0 || MIX == 3);
        const float mean_ = s1 * (1.f / 128.f), ex2 = s2 * (1.f / 128.f);
        const float mu = lnorm ? mean_ : 0.f;
        const float rs = rsqrtf((lnorm ? fmaxf(ex2 - mean_ * mean_, 0.f) : ex2) + 1e-5f);
        const int hcol = ((MIX & 1) ? 512 : 0) + h * 128 + d0;
        float gv[16]; unpack16(rg[0], rg[1], gv);
        float nw[16];
        if constexpr (MIX != 3) {
            const float* nwp = cx.norm_w + hcol;
#pragma unroll
            for (int q4 = 0; q4 < 4; ++q4) { const f32x4v x = *(const f32x4v*)(nwp + 4 * q4); nw[4 * q4] = x[0]; nw[4 * q4 + 1] = x[1]; nw[4 * q4 + 2] = x[2]; nw[4 * q4 + 3] = x[3]; }
        } else {
#pragma unroll
            for (int i = 0; i < 16; ++i) nw[i] = 1.f;
        }
#pragma unroll
        for (int i = 0; i < 16; ++i) {
            const float sg = __builtin_amdgcn_rcpf(1.0f + __expf(-gv[i]));
            const float gate = (MIX == 0) ? sg : gv[i] * sg;
            ov[i] = (ov[i] - mu) * rs * nw[i] * gate;
        }
        store16(cx.H + (row0 + t) * DM + hcol, ov);
        __syncthreads();
    }
}

template <int MODE>
__device__ __forceinline__ void phase_scan(const ScanCtx& cx, unsigned char* shm) {
    const int b = obid();
    if (cx.even) {
#pragma unroll 1
        for (int v = b; v < 1024; v += gridDim.x) scan_unit<MODE, 0>(cx, v >> 2, v & 3, shm);
#pragma unroll 1
        for (int v = b; v < 1024; v += gridDim.x) scan_unit<MODE, 1>(cx, v >> 2, v & 3, shm);
    } else {
#pragma unroll 1
        for (int v = b; v < 1024; v += gridDim.x) scan_unit<MODE, 2>(cx, v >> 2, v & 3, shm);
#pragma unroll 1
        for (int v = b; v < 1024; v += gridDim.x) scan_unit<MODE, 3>(cx, v >> 2, v & 3, shm);
    }
}

__device__ void phase_scan_prefix(const ScanCtx& cx, bool dry) {
    const int tid = otid();
    const int nseq = 256 / cx.cps;
    const int nunits = nseq * 16 * 16;
    for (int u = blockIdx.x; u < nunits; u += gridDim.x) {
        const int chain = u >> 4, sub = u & 15;
        const int seq = chain >> 4, hd = chain & 15, head = hd >> 1, dir = hd & 1;
        const int idx = sub * 512 + tid, e = idx >> 6, d = (idx & 63) * 2;
        const int dk = (cx.even && head >= 4) ? 64 : 128;
        const int cbase = seq * cx.cps, n = cx.cps;
        if (d < dk) {
            float s0 = 0.f, s1 = 0.f;
#pragma unroll 1
            for (int i0 = 0; i0 < n; i0 += 32) {
                unsigned wv[32]; f32x2c dc[32];
#pragma unroll
                for (int k = 0; k < 32; ++k) {
                    const int c = dir ? (cbase + n - 1 - (i0 + k)) : (cbase + i0 + k);
                    const size_t slot = (size_t)c * 16 + hd;
                    wv[k] = *(const unsigned*)(cx.ST + slot * 16384 + e * 128 + d);
                    dc[k] = *(const f32x2c*)(cx.DEC + slot * 128 + d);
                }
#pragma unroll
                for (int k = 0; k < 32; ++k) {
                    const int c = dir ? (cbase + n - 1 - (i0 + k)) : (cbase + i0 + k);
                    const size_t slot = (size_t)c * 16 + hd;
                    *(unsigned*)(cx.ST + slot * 16384 + e * 128 + d) = dry ? wv[k] : pk2(s0, s1);
                    s0 = dc[k][0] * s0 + __uint_as_float(wv[k] << 16);
                    s1 = dc[k][1] * s1 + __uint_as_float(wv[k] & 0xffff0000u);
                }
            }
        }
        if (cx.even && head < 4 && sub == 0 && tid < 128) {
            float s = 0.f;
#pragma unroll 1
            for (int i0 = 0; i0 < n; i0 += 8) {
                float dl[8], dc[8];
#pragma unroll
                for (int k = 0; k < 8; ++k) {
                    const int c = dir ? (cbase + n - 1 - (i0 + k)) : (cbase + i0 + k);
                    dl[k] = cx.NV[((size_t)c * 8 + head * 2 + dir) * 128 + tid];
                    dc[k] = cx.DEC[((size_t)c * 16 + hd) * 128 + tid];
                }
#pragma unroll
                for (int k = 0; k < 8; ++k) {
                    const int c = dir ? (cbase + n - 1 - (i0 + k)) : (cbase + i0 + k);
                    cx.NV[((size_t)c * 8 + head * 2 + dir) * 128 + tid] = dry ? dl[k] : s;
                    s = dc[k] * s + dl[k];
                }
            }
        }
    }
}

constexpr int PH_PER_LAYER = 31, N_PHASES = 1 + 4 * PH_PER_LAYER;

__device__ void run_phase(const Params& p, int ph, unsigned char* shm, bool dry) {
    if (ph == 0) { phase_prep(p, shm); return; }
    const int l = (ph - 1) / PH_PER_LAYER, s = (ph - 1) % PH_PER_LAYER, j = l >> 1, even = !(l & 1);
    u16* XB = (u16*)(p.ws + WS_XB);
    if (s < 5 || s >= 26) {
        const int which = (s >= 26), ss = which ? s - 26 : s;
        if (ss == 4) { phase_ln(p, p.in[6] + (l * 3 + (which ? 2 : 0)) * DM, p.in[7] + (l * 3 + (which ? 2 : 0)) * DM, which && l == 3); return; }
        const int half = ss >> 1;
        u16* ACT = (u16*)(p.ws + WS_ACT);
        if ((ss & 1) == 0) {
            EpiSwiGLU E; E.O = ACT; E.ldc = DFF;
            run_gemm(shm, XB + (size_t)half * HALF_ROWS * DM, (const u16*)(p.ws + WS_FFN_IN + (size_t)(which * 4 + l) * SZ_FFN_IN), HALF_ROWS, 5632, 1024, E);
        } else {
            EpiResid E; E.X = p.X + (size_t)half * HALF_ROWS * DM; E.src = E.X; E.scale = 0.5f; E.dry = dry;
            const int lnidx = which ? (l * 3 + 1) : (l * 3 - 1);
            if (lnidx < 0) { E.stats = nullptr; E.g = nullptr; E.b = nullptr; E.src = p.in[half]; }
            else { E.stats = (const float*)(p.ws + WS_STATS) + 2 * (size_t)half * HALF_ROWS; E.g = p.in[6] + lnidx * DM; E.b = p.in[7] + lnidx * DM; }
            run_gemm(shm, ACT, (const u16*)(p.ws + WS_FFN_OUT + (size_t)(which * 4 + l) * SZ_FFN_OUT), HALF_ROWS, 1024, DFF, E);
        }
        return;
    }
    if (s == 25) { phase_ln(p, p.in[6] + (l * 3 + 1) * DM, p.in[7] + (l * 3 + 1) * DM, false); return; }
    const int q = (s - 5) / 5, k = (s - 5) % 5;
    ScanCtx cx;
    cx.Y = (const u16*)(p.ws + WS_Y); cx.ld = even ? EVC : ODC;
    cx.H = XB + (size_t)q * Q_ROWS * DM;
    cx.ST = (u16*)(p.ws + WS_ST); cx.DEC = (float*)(p.ws + WS_DEC); cx.NV = (float*)(p.ws + WS_NV);
    cx.cps = (q < 2) ? 256 : 64; cx.even = even; cx.j = j;
    cx.gate_b = p.in[9] + j * 16; cx.conv_w = p.in[10] + j * 5 * 1024; cx.a2_w = p.in[11] + (size_t)j * 2 * 16 * 256; cx.a2_b = p.in[12] + j * 2 * 256;
    cx.norm_w = even ? (p.in[13] + j * 1024) : (p.in[17] + j * 512);
    cx.lb_logits = p.in[16];
    cx.rope = (const double*)(p.ws + WS_ROPE); cx.omlb = (const float*)(p.ws + WS_OMLB);
    if (k == 0) {
        EpiBf16 E; E.O = (u16*)(p.ws + WS_Y); E.ldc = cx.ld;
        const u16* Bt = even ? (const u16*)(p.ws + WS_EV_IN + (size_t)j * SZ_EV_IN) : (const u16*)(p.ws + WS_OD_IN + (size_t)j * SZ_OD_IN);
        run_gemm(shm, XB + (size_t)q * Q_ROWS * DM, Bt, Q_ROWS, cx.ld, 1024, E);
    } else if (k == 1) {
        phase_scan<0>(cx, shm);
    } else if (k == 2) {
        phase_scan_prefix(cx, dry);
    } else if (k == 3) {
        phase_scan<1>(cx, shm);
    } else {
        EpiResid E; E.X = p.X; E.src = E.X; E.scale = 1.0f; E.dry = dry;
        E.stats = (const float*)(p.ws + WS_STATS); E.g = p.in[6] + (l * 3) * DM; E.b = p.in[7] + (l * 3) * DM;
        const u16* Bt = even ? (const u16*)(p.ws + WS_EV_OUT + (size_t)j * SZ_SQ) : (const u16*)(p.ws + WS_OD_OUT + (size_t)j * SZ_SQ);
        run_gemm(shm, XB, Bt, NTOK, 1024, 1024, E);
    }
}

#ifndef PROBE_MASK
#define PROBE_MASK 0
#endif
__device__ __forceinline__ bool probe_repeat(int ph) {
    if (ph == 0) return (PROBE_MASK & 4) != 0;
    const int s = (ph - 1) % PH_PER_LAYER;
    if (s < 5 || s >= 26) { const int ss = s >= 26 ? s - 26 : s; if (ss == 4) return (PROBE_MASK & 16) && !(s >= 26 && (ph - 1) / PH_PER_LAYER == 3); if (ss == 1 || ss == 3) return (PROBE_MASK & 64) && (ph > 5); return (PROBE_MASK & 2) && (ss == 0 || ss == 2); }
    if (s == 25) return (PROBE_MASK & 16) != 0;
    const int k = (s - 5) % 5;
    if (k == 0) return (PROBE_MASK & 2) != 0;
    if (k == 1 || k == 3) return (PROBE_MASK & 1) != 0;
    if (k == 2) return (PROBE_MASK & 32) != 0;
    if (k == 4) return (PROBE_MASK & 64) != 0;
    return false;
}
constexpr size_t WS_BAR = WS_STATS + (size_t)NTOK * 8;
constexpr size_t LDS_MAIN = SCAN_LDS > 131072 ? SCAN_LDS : 131072;
__device__ __forceinline__ bool phase_is_noop(int ph) {
    if (ph == 0) return false;
    const int s = (ph - 1) % PH_PER_LAYER;
    return s >= 5 && s < 25 && ((s - 5) % 5) == 4 && ((s - 5) / 5) < 3;
}
template <bool COOP>
__global__ __launch_bounds__(512, 2) void hybrid_mega(Params p, int ph0, int ph1) {
    extern __shared__ __attribute__((aligned(16))) unsigned char shm[];
    volatile LAS unsigned* st = (volatile LAS unsigned*)((LAS unsigned char*)shm + LDS_MAIN);
    if (threadIdx.x == 0) { st[0] = 0u; st[1] = 0u; st[2] = 0u; st[3] = 0u; }
    __syncthreads();
    XcdBarrier xb = xcd_barrier_post((unsigned*)(p.ws + WS_BAR), st);
    for (int ph = ph0; ph < ph1; ++ph) {
        if (phase_is_noop(ph)) continue;
#if PROBE_MASK
        const int nrep = probe_repeat(ph) ? 2 : 1;
#pragma unroll 1
        for (int rep = 0; rep < nrep; ++rep) {
            run_phase(p, ph, shm, rep > 0);
            if (COOP) { if (ph == 0 && rep == 0) cg::this_grid().sync(); else xcd_barrier(xb); }
            if (PROBE_MASK & 8) { if (COOP) xcd_barrier(xb); }
        }
#else
        run_phase(p, ph, shm, false);
        if (COOP && ph + 1 < ph1) { if (ph == 0) cg::this_grid().sync(); else xcd_barrier(xb); }
#endif
    }
}

#ifndef USE_COOP
#define USE_COOP 1
#endif

extern "C" void kernel_launch(void* const* d_in, const int* in_sizes, int n_in, void* d_out, int out_size, void* d_ws, size_t ws_size, hipStream_t stream) {
    (void)in_sizes; (void)n_in; (void)out_size; (void)ws_size;
    Params p{};
    for (int i = 0; i < 19; ++i) p.in[i] = (const float*)d_in[i];
    p.X = (float*)d_out; p.ws = (unsigned char*)d_ws;
    constexpr size_t kLds = LDS_MAIN + 16;
#if USE_COOP
    static int grid_blocks = 0;
    if (!grid_blocks) {
        hipFuncSetAttribute((const void*)hybrid_mega<true>, hipFuncAttributeMaxDynamicSharedMemorySize, (int)kLds);
        int dev = 0, cus = 0, per_cu = 0;
        hipGetDevice(&dev);
        hipDeviceGetAttribute(&cus, hipDeviceAttributeMultiprocessorCount, dev);
        hipOccupancyMaxActiveBlocksPerMultiprocessor(&per_cu, hybrid_mega<true>, 512, kLds);
        if (per_cu < 1) per_cu = 1;
        grid_blocks = cus * 1;
    }
    hipMemsetAsync((unsigned char*)d_ws + WS_BAR, 0, XCD_BAR_WORDS * sizeof(unsigned), stream);
    int ph0 = 0, ph1 = N_PHASES;
    void* args[] = {&p, &ph0, &ph1};
    hipLaunchCooperativeKernel((const void*)hybrid_mega<true>, dim3(grid_blocks), dim3(512), args, kLds, stream);
#else
    static int inited = 0;
    if (!inited) { hipFuncSetAttribute((const void*)hybrid_mega<false>, hipFuncAttributeMaxDynamicSharedMemorySize, (int)kLds); inited = 1; }
    for (int ph = 0; ph < N_PHASES; ++ph) hybrid_mega<false><<<256, 512, kLds, stream>>>(p, ph, ph + 1);
#endif
}
```

```cpp
#define PROBE_MASK 0
#include <hip/hip_runtime.h>
#include <hip/hip_cooperative_groups.h>
namespace pg8 {
#define PG8_LAS __attribute__((address_space(3)))
typedef unsigned short bf16_t;
typedef short bf16x8 __attribute__((ext_vector_type(8)));
typedef float f32x4 __attribute__((ext_vector_type(4)));
typedef unsigned u32x4 __attribute__((ext_vector_type(4)));
constexpr int BM = 256, BK = 64, HALF = 128, HTB = HALF * BK * 2  , STAGE_BYTES = 8 * HTB, NXCD = 8, WGM = 8;

__host__ __device__ __forceinline__ int lds_byte(int r, int c) { const int st = (r >> 4) * 2 + (c >> 5), rr = r & 15, cc = c & 31, ob = rr * 64 + cc * 2; return st * 1024 + (ob ^ (((ob >> 9) & 1) << 5)); }
__host__ __device__ __forceinline__ void stage_rc(int b, int& R, int& C) { const int st = b / 1024, sb = b % 1024, swz = sb ^ (((sb >> 9) & 1) << 5); R = (st >> 1) * 16 + swz / 64; C = (st & 1) * 32 + (swz % 64) / 2; }
__host__ __device__ __forceinline__ int perm32(int rho) { const int n = rho >> 4, i = rho & 15; return 8 * (i >> 2) + 4 * n + (i & 3); }

struct Unit { int pm, pn; };
struct Gemm { const bf16_t* A; const bf16_t* Bt; int M, N, K; };

struct StaticOrder {
    int nM, nN, nwg, G, c;
    __host__ __device__ void init(int M, int N, int G_, int c_) { nM = M / BM; nN = N / BM; nwg = nM * nN; G = G_; c = c_; }
    __host__ __device__ bool next(int i, Unit& u) const {
        const long L = (long)i * G + c; if (L >= nwg) return false;
        int wgid = (int)L; { const int q = nwg / NXCD, r = nwg % NXCD, xcd = wgid % NXCD, off = wgid / NXCD; wgid = (xcd < r ? xcd * (q + 1) : r * (q + 1) + (xcd - r) * q) + off; }
        const int nig = WGM * nN, gid = wgid / nig, fm = gid * WGM, gsz = (nM - fm) < WGM ? (nM - fm) : WGM;
        u.pm = fm + ((wgid % nig) % gsz); u.pn = (wgid % nig) / gsz; return true;
    }
    __device__ __forceinline__ void a_ready(const Unit&) const {}
    __device__ __forceinline__ void done(const Unit&) const {}
};
__device__ __forceinline__ unsigned cvt_pk_bf16(float lo, float hi) { unsigned r; asm volatile("v_cvt_pk_bf16_f32 %0, %1, %2" : "=v"(r) : "v"(lo), "v"(hi)); return r; }

template <class Epi, class Sched, bool STAMP = false>
__device__ __forceinline__ void gemm_phase(PG8_LAS unsigned char* lds, const Gemm g, const Sched& S, const Epi& E, unsigned long long* stamps) {
    int tid_o = threadIdx.x; asm volatile("" : "+v"(tid_o)); const int tid = tid_o, wid = __builtin_amdgcn_readfirstlane(tid >> 6), lane = tid & 63, wr = wid >> 2, wc = wid & 3, fr = lane & 15, fq = lane >> 4;
    const int K = g.K, nt = K / BK;
    int ts_lo = 0, ts_hi = 0, nts = 0; const unsigned long long rt_entry = STAMP ? (unsigned long long)wall_clock64() : 0ull;
#define PG8_STAMP() do { if (STAMP && wid == 0 && nts < 64) { const unsigned long long _c = (unsigned long long)clock64(); \
        ts_lo = (lane == nts) ? (int)(unsigned)_c : ts_lo; ts_hi = (lane == nts) ? (int)(unsigned)(_c >> 32) : ts_hi; ++nts; } } while (0)
    PG8_STAMP();
    unsigned voffA[2], voffB[2];
#pragma unroll
    for (int i = 0; i < 2; ++i) { int R, C; stage_rc(tid * 16 + i * 8192, R, C); const int Rb = Epi::PERM ? ((R & ~31) + perm32(R & 31)) : R;
        voffA[i] = (unsigned)(R * K + C) * 2u; voffB[i] = (unsigned)(Rb * K + C) * 2u; }
    const size_t kstep = (size_t)(BK * 2);
    const size_t hstep = (size_t)HALF * K * 2;
    const size_t tstep = 2 * hstep;
    const unsigned ldsw = (unsigned)wid * 1024u;
    const int aoff = lds_byte(wr * 64 + fr, fq * 8), boff = lds_byte(wc * 32 + fr, fq * 8);
#define PG8_SA(b, h) (((b) * 2 + (h)) * HTB)
#define PG8_SB(b, h) ((4 + (b) * 2 + (h)) * HTB)
#define PG8_STAGE(bufoff, gbase, voff) do { _Pragma("unroll") for (int _i = 0; _i < 2; ++_i) \
        __builtin_amdgcn_global_load_lds((const unsigned*)((const char*)(gbase) + (voff)[_i]), (PG8_LAS unsigned*)(lds + (bufoff) + ldsw + _i * 8192), 16, 0, 0); } while (0)
#define PG8_LDA(dst, b, h) do { _Pragma("unroll") for (int m = 0; m < 4; ++m) _Pragma("unroll") for (int k = 0; k < 2; ++k) dst[m][k] = *(const PG8_LAS bf16x8*)(lds + PG8_SA(b, h) + aoff + m * 2048 + k * 1024); } while (0)
#define PG8_LDB(dst, b, h) do { _Pragma("unroll") for (int n = 0; n < 2; ++n) _Pragma("unroll") for (int k = 0; k < 2; ++k) dst[n][k] = *(const PG8_LAS bf16x8*)(lds + PG8_SB(b, h) + boff + n * 2048 + k * 1024); } while (0)
#define PG8_MMA(ai, bj, At, Bt) do { __builtin_amdgcn_s_setprio(1); _Pragma("unroll") for (int m = 0; m < 4; ++m) _Pragma("unroll") for (int n = 0; n < 2; ++n) _Pragma("unroll") for (int k = 0; k < 2; ++k) \
        acc[ai][bj][m][n] = __builtin_amdgcn_mfma_f32_16x16x32_bf16(Bt[n][k], At[m][k], acc[ai][bj][m][n], 0, 0, 0); __builtin_amdgcn_s_setprio(0); } while (0)
#define PG8_WAIT_V(n) asm volatile("s_waitcnt vmcnt(" #n ")" ::: "memory")
#define PG8_WAIT_L(n) asm volatile("s_waitcnt lgkmcnt(" #n ")" ::: "memory")
#define PG8_BAR __builtin_amdgcn_s_barrier()
#define PG8_SCHED __builtin_amdgcn_sched_barrier(0)
    Unit cur, nxt; int ui = 0;
    if (!S.next(0, cur)) return;
    f32x4 acc[2][2][4][2];
#pragma unroll
    for (int a = 0; a < 2; ++a)
#pragma unroll
        for (int b = 0; b < 2; ++b)
#pragma unroll
            for (int m = 0; m < 4; ++m)
#pragma unroll
                for (int n = 0; n < 2; ++n) { if constexpr (Epi::HAS_INIT) acc[a][b][m][n] = E.init(cur, wr, wc, fr, fq, a, b, m, n); else acc[a][b][m][n] = (f32x4){0.f, 0.f, 0.f, 0.f}; }
    bf16x8 At[4][2], B0[2][2], B1[2][2];
    const char* cA = (const char*)g.A + (size_t)cur.pm * tstep; const char* cB = (const char*)g.Bt + (size_t)cur.pn * tstep;
    S.a_ready(cur);
    PG8_STAGE(PG8_SB(0, 0), cB, voffB); PG8_STAGE(PG8_SA(0, 0), cA, voffA); PG8_STAGE(PG8_SB(0, 1), cB + hstep, voffB); PG8_STAGE(PG8_SA(0, 1), cA + hstep, voffA);
    if (wr == 1) PG8_BAR;
    PG8_WAIT_V(4); PG8_BAR;
    PG8_STAGE(PG8_SB(1, 0), cB + kstep, voffB); PG8_STAGE(PG8_SA(1, 0), cA + kstep, voffA); PG8_STAGE(PG8_SB(1, 1), cB + hstep + kstep, voffB);
    PG8_WAIT_V(6); PG8_BAR;
    PG8_STAMP();
    for (;;) {
        const bool has_next = S.next(ui + 1, nxt);
        const char* nA = has_next ? (const char*)g.A + (size_t)nxt.pm * tstep : cA; const char* nB = has_next ? (const char*)g.Bt + (size_t)nxt.pn * tstep : cB;
        for (int t = 0; t < nt; t += 2) {
            const bool last = (t == nt - 2);
            const char* a1 = cA + (size_t)(t + 1) * kstep;
            const char* a2 = last ? nA : cA + (size_t)(t + 2) * kstep; const char* b2 = last ? nB : cB + (size_t)(t + 2) * kstep;
            const char* a3 = a2 + kstep; const char* b3 = b2 + kstep;
            if (last && has_next) S.a_ready(nxt);
            PG8_LDB(B0, 0, 0); PG8_SCHED; PG8_LDA(At, 0, 0); PG8_STAGE(PG8_SA(1, 1), a1 + hstep, voffA);
            PG8_WAIT_L(8); PG8_BAR; PG8_WAIT_L(0); PG8_MMA(0, 0, At, B0); PG8_BAR; PG8_SCHED;
            PG8_LDB(B1, 0, 1); PG8_STAGE(PG8_SB(0, 0), b2, voffB);
            PG8_BAR; PG8_WAIT_L(0); PG8_MMA(0, 1, At, B1); PG8_BAR;
            PG8_LDA(At, 0, 1); PG8_STAGE(PG8_SA(0, 0), a2, voffA);
            PG8_BAR; PG8_WAIT_L(0); PG8_MMA(1, 0, At, B0); PG8_BAR; PG8_SCHED;
            PG8_STAGE(PG8_SB(0, 1), b2 + hstep, voffB);
            PG8_WAIT_V(6); PG8_BAR; PG8_MMA(1, 1, At, B1); PG8_BAR;
            PG8_LDB(B0, 1, 0); PG8_SCHED; PG8_LDA(At, 1, 0); PG8_STAGE(PG8_SA(0, 1), a2 + hstep, voffA);
            PG8_WAIT_L(8); PG8_BAR; PG8_WAIT_L(0); PG8_MMA(0, 0, At, B0); PG8_BAR; PG8_SCHED;
            PG8_LDB(B1, 1, 1); PG8_STAGE(PG8_SB(1, 0), b3, voffB);
            PG8_BAR; PG8_WAIT_L(0); PG8_MMA(0, 1, At, B1); PG8_BAR;
            PG8_LDA(At, 1, 1); PG8_STAGE(PG8_SA(1, 0), a3, voffA);
            PG8_BAR; PG8_WAIT_L(0); PG8_MMA(1, 0, At, B0); PG8_BAR; PG8_SCHED;
            PG8_STAGE(PG8_SB(1, 1), b3 + hstep, voffB);
            PG8_WAIT_V(6); PG8_BAR; PG8_MMA(1, 1, At, B1); PG8_BAR;
        }
        PG8_STAMP();
        if constexpr (!Epi::AFTER_DRAIN) { E(acc, cur, wr, wc, fr, fq); S.done(cur); }
        PG8_STAMP();
        if (!has_next) break;
#pragma unroll
        for (int a = 0; a < 2; ++a)
#pragma unroll
            for (int b = 0; b < 2; ++b)
#pragma unroll
                for (int m = 0; m < 4; ++m)
#pragma unroll
                    for (int n = 0; n < 2; ++n) { if constexpr (Epi::HAS_INIT) acc[a][b][m][n] = E.init(nxt, wr, wc, fr, fq, a, b, m, n); else acc[a][b][m][n] = (f32x4){0.f, 0.f, 0.f, 0.f}; }
        cur = nxt; cA = nA; cB = nB; ++ui;
    }
    PG8_WAIT_V(0);
    if (wr == 0) PG8_BAR;
    PG8_BAR;
    if constexpr (Epi::AFTER_DRAIN) { E.fused(acc, cur, wr, wc, fr, fq, lds, wid, lane); S.done(cur); }
    PG8_STAMP();
    if (STAMP && wid == 0) { stamps[lane] = lane < nts ? (((unsigned long long)(unsigned)ts_hi << 32) | (unsigned)ts_lo) : 0ull;
        if (lane == 62) stamps[62] = rt_entry; if (lane == 63) stamps[63] = (unsigned long long)wall_clock64(); }
#undef PG8_STAMP
#undef PG8_SA
#undef PG8_SB
#undef PG8_STAGE
#undef PG8_LDA
#undef PG8_LDB
#undef PG8_MMA
#undef PG8_WAIT_V
#undef PG8_WAIT_L
#undef PG8_BAR
#undef PG8_SCHED
}
}
#define XB_TMO      128
#define XB_XCNT(j)  (256  + 64 * (j))
#define XB_XSUB(j)  (1280 + 64 * (j))
#define XB_XGEN(j)  (2304 + 64 * (j))
#define XB_TOP      3328
#define XB_TOPGEN   3392
#define XCD_BAR_WORDS 3456
#define XB_SPIN_CAP (1u << 18)
#define LAS __attribute__((address_space(3)))

__device__ __forceinline__ unsigned xb_ld(unsigned* p)              { return __hip_atomic_load(p, __ATOMIC_RELAXED, __HIP_MEMORY_SCOPE_AGENT); }
__device__ __forceinline__ unsigned xb_add(unsigned* p, unsigned v) { return __hip_atomic_fetch_add(p, v, __ATOMIC_RELAXED, __HIP_MEMORY_SCOPE_AGENT); }
__device__ __forceinline__ unsigned xb_xcc_id() { return (unsigned)__builtin_amdgcn_s_getreg((3 << 11) | 20) & 0xFu; }
#define XB_SPIN(cond, bar) do { unsigned _sp = 0; while (cond) { __builtin_amdgcn_s_sleep(1); \
    if ((++_sp & 255u) == 0u) { if (xb_ld(&(bar)[XB_TMO])) break; if (_sp > XB_SPIN_CAP) { atomicAdd(&(bar)[XB_TMO], 1u); break; } } } } while (0)

struct XcdBarrier {
    unsigned* bar; unsigned x;
    volatile LAS unsigned* st;
};

__device__ __forceinline__ XcdBarrier xcd_barrier_post(unsigned* bar, volatile LAS unsigned* st) {
    XcdBarrier b; b.bar = bar; b.x = xb_xcc_id(); b.st = st;
    if (threadIdx.x == 0) (void)xb_add(&bar[XB_XCNT(b.x)], 1u);
    return b;
}
__device__ __forceinline__ void xcd_barrier_complete(unsigned* bar, unsigned x, unsigned& nloc, unsigned& nx) {
    const unsigned G = gridDim.x * gridDim.y * gridDim.z;
    unsigned sum, cnt, mine, sp = 0u;
    for (;;) {
        sum = 0u; cnt = 0u; mine = 0u;
#pragma unroll
        for (unsigned j = 0; j < 16; ++j) { const unsigned c = xb_ld(&bar[XB_XCNT(j)]); sum += c; cnt += (c > 0u) ? 1u : 0u; mine = (j == x) ? c : mine; }
        if (sum == G) break;
        __builtin_amdgcn_s_sleep(1);
        if ((++sp & 255u) == 0u) { if (xb_ld(&bar[XB_TMO])) break; if (sp > XB_SPIN_CAP) { atomicAdd(&bar[XB_TMO], 1u); break; } }
    }
    nloc = mine > 0u ? mine : 1u; nx = cnt > 0u ? cnt : 1u;
}

__device__ __forceinline__ void xcd_barrier(const XcdBarrier& b) {
    asm volatile("s_waitcnt vmcnt(0)" ::: "memory");
    __syncthreads();
    if (threadIdx.x == 0) {
        unsigned* bar = b.bar;
        __builtin_amdgcn_s_waitcnt(0);
        unsigned nloc = b.st[0], nx = b.st[1];
        if (nloc == 0u) { xcd_barrier_complete(bar, b.x, nloc, nx); b.st[0] = nloc; b.st[1] = nx; }
        const unsigned old = xb_add(&bar[XB_XSUB(b.x)], 1u);
        const unsigned gen = old / nloc;
        if (old + 1u == (gen + 1u) * nloc) {
            __builtin_amdgcn_fence(__ATOMIC_RELEASE, "agent");
            asm volatile("s_waitcnt vmcnt(0)" ::: "memory");
            const unsigned og = xb_add(&bar[XB_TOP], 1u);
            const unsigned tg = og / nx;
            if (og + 1u == (tg + 1u) * nx) xb_add(&bar[XB_TOPGEN], 1u);
            else XB_SPIN(xb_ld(&bar[XB_TOPGEN]) == tg, bar);
            __builtin_amdgcn_fence(__ATOMIC_ACQUIRE, "agent");
            xb_add(&bar[XB_XGEN(b.x)], 1u);
            asm volatile("s_waitcnt vmcnt(0)" ::: "memory");
        } else {
            XB_SPIN(xb_ld(&bar[XB_XGEN(b.x)]) == gen, bar);
            __builtin_amdgcn_fence(__ATOMIC_ACQUIRE, "agent");
            asm volatile("s_waitcnt vmcnt(0)" ::: "memory");
        }
    }
    __syncthreads();
}

namespace cg = cooperative_groups;
__device__ __forceinline__ int otid() { int t = threadIdx.x; asm volatile("" : "+v"(t)); return t; }
__device__ __forceinline__ int obid() { int b = blockIdx.x; asm volatile("" : "+s"(b)); return b; }
typedef unsigned short u16;
using pg8::bf16x8; using pg8::f32x4;
typedef unsigned u32x4v __attribute__((ext_vector_type(4)));
typedef unsigned u32x2v __attribute__((ext_vector_type(2)));
typedef float f32x4v __attribute__((ext_vector_type(4)));

constexpr int NTOK = 65536, DM = 1024, DFF = 2816;
constexpr int EVC = 3840, ODC = 4608;
constexpr float ALPHA_F = 1.681792830507429f;
constexpr int HALF_ROWS = 32768, Q_ROWS = 16384;

constexpr size_t SZ_FFN_IN = (size_t)5632 * 1024 * 2, SZ_FFN_OUT = (size_t)1024 * 2816 * 2;
constexpr size_t SZ_EV_IN = (size_t)EVC * 1024 * 2, SZ_OD_IN = (size_t)ODC * 1024 * 2, SZ_SQ = (size_t)1024 * 1024 * 2;
constexpr size_t WS_FFN_IN = 0;
constexpr size_t WS_FFN_OUT = WS_FFN_IN + 8 * SZ_FFN_IN;
constexpr size_t WS_EV_IN = WS_FFN_OUT + 8 * SZ_FFN_OUT;
constexpr size_t WS_OD_IN = WS_EV_IN + 2 * SZ_EV_IN;
constexpr size_t WS_EV_OUT = WS_OD_IN + 2 * SZ_OD_IN;
constexpr size_t WS_OD_OUT = WS_EV_OUT + 2 * SZ_SQ;
constexpr size_t WS_XB = WS_OD_OUT + 2 * SZ_SQ;
constexpr size_t WS_ROPE = WS_XB + (size_t)NTOK * DM * 2;
constexpr size_t WS_OMLB = WS_ROPE + 4096;
constexpr size_t WS_SCR = WS_ROPE + 16384;
constexpr size_t SZ_Y = (size_t)Q_ROWS * ODC * 2;
constexpr size_t SZ_ST = (size_t)256 * 16 * 16384 * 2;
constexpr size_t SZ_DEC = (size_t)256 * 16 * 128 * 4;
constexpr size_t SZ_NV = (size_t)256 * 8 * 128 * 4;
constexpr size_t WS_Y = WS_SCR, WS_ST = WS_Y + SZ_Y, WS_DEC = WS_ST + SZ_ST, WS_NV = WS_DEC + SZ_DEC, WS_END = WS_NV + SZ_NV;
constexpr size_t WS_STATS = WS_END;
constexpr size_t WS_ACT = WS_SCR;

struct Params {
    const float* in[19];
    float* X;
    unsigned char* ws;
};

__device__ __forceinline__ float bf2f(u16 b) { return __uint_as_float(((unsigned)b) << 16); }
__device__ __forceinline__ u16 f2bf(float f) { unsigned u = __float_as_uint(f); u += 0x7FFFu + ((u >> 16) & 1u); return (u16)(u >> 16); }
typedef float f32x2c __attribute__((ext_vector_type(2)));
typedef __bf16 bf16x2c __attribute__((ext_vector_type(2)));
__device__ __forceinline__ unsigned pk2(float lo, float hi) { f32x2c v = {lo, hi}; bf16x2c r = __builtin_convertvector(v, bf16x2c); return __builtin_bit_cast(unsigned, r); }
__device__ __forceinline__ float sigmoidf_(float x) { return __builtin_amdgcn_rcpf(1.0f + __expf(-x)); }
__device__ __forceinline__ float siluf_(float x) { return x * __builtin_amdgcn_rcpf(1.0f + __expf(-x)); }
__device__ __forceinline__ float logsigf_(float x) { return fminf(x, 0.f) - __logf(1.0f + __expf(-fabsf(x))); }
__device__ __forceinline__ float expc(float x) { return __expf(fminf(x, 80.f)); }
__device__ __forceinline__ void load16(const u16* p, float* o) {
    const u32x4v a = *(const u32x4v*)p, b = *(const u32x4v*)(p + 8);
#pragma unroll
    for (int i = 0; i < 4; ++i) { o[2 * i] = __uint_as_float(a[i] << 16); o[2 * i + 1] = __uint_as_float(a[i] & 0xffff0000u);
                                  o[8 + 2 * i] = __uint_as_float(b[i] << 16); o[8 + 2 * i + 1] = __uint_as_float(b[i] & 0xffff0000u); }
}
__device__ __forceinline__ void store16(u16* p, const float* v) {
    u32x4v a, b;
#pragma unroll
    for (int i = 0; i < 4; ++i) { a[i] = pk2(v[2 * i], v[2 * i + 1]); b[i] = pk2(v[8 + 2 * i], v[8 + 2 * i + 1]); }
    *(u32x4v*)p = a; *(u32x4v*)(p + 8) = b;
}

struct EpiSwiGLU {
    static constexpr bool PERM = true, AFTER_DRAIN = false, HAS_INIT = false;
    u16* O; int ldc;
    __device__ __forceinline__ void operator()(const f32x4 (&acc)[2][2][4][2], const pg8::Unit& u, int wr, int wc, int fr, int fq) const {
        const int row0 = u.pm * 256 + wr * 64 + fr, col0 = u.pn * 128 + wc * 32 + 8 * fq;
#pragma unroll
        for (int ai = 0; ai < 2; ++ai)
#pragma unroll
            for (int m = 0; m < 4; ++m) {
                u16* dst = O + (size_t)(row0 + ai * 128 + m * 16) * ldc + col0;
                float v[8];
#pragma unroll
                for (int n = 0; n < 2; ++n)
#pragma unroll
                    for (int j = 0; j < 4; ++j) { const float g = acc[ai][0][m][n][j], uu = acc[ai][1][m][n][j]; v[4 * n + j] = siluf_(g) * uu; }
                u32x4v o; o[0] = pk2(v[0], v[1]); o[1] = pk2(v[2], v[3]); o[2] = pk2(v[4], v[5]); o[3] = pk2(v[6], v[7]);
                *(u32x4v*)dst = o;
            }
    }
};
struct EpiBf16 {
    static constexpr bool PERM = true, AFTER_DRAIN = false, HAS_INIT = false;
    u16* O; int ldc;
    __device__ __forceinline__ void operator()(const f32x4 (&acc)[2][2][4][2], const pg8::Unit& u, int wr, int wc, int fr, int fq) const {
        const int row0 = u.pm * 256 + wr * 64 + fr, col0 = u.pn * 256 + wc * 32 + 8 * fq;
#pragma unroll
        for (int ai = 0; ai < 2; ++ai)
#pragma unroll
            for (int m = 0; m < 4; ++m)
#pragma unroll
                for (int bj = 0; bj < 2; ++bj) {
                    u16* dst = O + (size_t)(row0 + ai * 128 + m * 16) * ldc + col0 + bj * 128;
                    const f32x4 a = acc[ai][bj][m][0], b = acc[ai][bj][m][1];
                    u32x4v o; o[0] = pk2(a[0], a[1]); o[1] = pk2(a[2], a[3]); o[2] = pk2(b[0], b[1]); o[3] = pk2(b[2], b[3]);
                    *(u32x4v*)dst = o;
                }
    }
};
struct EpiResid {
    static constexpr bool PERM = false, AFTER_DRAIN = false, HAS_INIT = true;
    float* X; const float* src; float scale; const float* stats; const float* g; const float* b; bool dry;
    __device__ __forceinline__ f32x4 init(const pg8::Unit& u, int wr, int wc, int fr, int fq, int ai, int bj, int m, int n) const {
        const size_t row = (size_t)(u.pm * 256 + wr * 64 + fr + ai * 128 + m * 16);
        const int col = u.pn * 256 + wc * 32 + 4 * fq + bj * 128 + n * 16;
        f32x4v old = *(const f32x4v*)(src + row * DM + col);
        if (stats) { const f32x2c st = *(const f32x2c*)(stats + 2 * row); const f32x4v gv = *(const f32x4v*)(g + col), bv = *(const f32x4v*)(b + col);
            old = (old - st[0]) * st[1] * gv + bv; }
        const float k = ALPHA_F / scale;
        f32x4 r; r[0] = old[0] * k; r[1] = old[1] * k; r[2] = old[2] * k; r[3] = old[3] * k;
        return r;
    }
    __device__ __forceinline__ void operator()(const f32x4 (&acc)[2][2][4][2], const pg8::Unit& u, int wr, int wc, int fr, int fq) const {
        if (dry) return;
        const int row0 = u.pm * 256 + wr * 64 + fr, col0 = u.pn * 256 + wc * 32 + 4 * fq;
#pragma unroll
        for (int ai = 0; ai < 2; ++ai)
#pragma unroll
            for (int m = 0; m < 4; ++m) {
                float* rowp = X + (size_t)(row0 + ai * 128 + m * 16) * DM + col0;
#pragma unroll
                for (int bj = 0; bj < 2; ++bj)
#pragma unroll
                    for (int n = 0; n < 2; ++n) {
                        const f32x4 a = acc[ai][bj][m][n];
                        f32x4v r; r[0] = scale * a[0]; r[1] = scale * a[1]; r[2] = scale * a[2]; r[3] = scale * a[3];
                        *(f32x4v*)(rowp + bj * 128 + n * 16) = r;
                    }
            }
    }
};

template <class Epi>
__device__ __forceinline__ void run_gemm(unsigned char* shm, const u16* A, const u16* Bt, int M, int N, int K, const Epi& E) {
    pg8::Gemm g; g.A = A; g.Bt = Bt; g.M = M; g.N = N; g.K = K;
    pg8::StaticOrder S; S.init(M, N, (int)gridDim.x, obid());
    pg8::gemm_phase<Epi, pg8::StaticOrder, false>((PG8_LAS unsigned char*)shm, g, S, E, nullptr);
    __syncthreads();
}

__device__ __forceinline__ void transpose_tile(unsigned char* shm, const float* src, int K, int Nsrc, u16* dst, int r0, int n0, int k0) {
    float* tile = (float*)shm;
    const int tid = otid();
    {
        const int r = tid >> 4, c4 = (tid & 15) * 4;
#pragma unroll
        for (int i = 0; i < 2; ++i) {
            const int k = r + 32 * i;
            f32x4v v = {0.f, 0.f, 0.f, 0.f};
            if (n0 + c4 < Nsrc) v = *(const f32x4v*)(src + (size_t)(k0 + k) * Nsrc + n0 + c4);
            tile[k * 65 + c4 + 0] = v[0]; tile[k * 65 + c4 + 1] = v[1]; tile[k * 65 + c4 + 2] = v[2]; tile[k * 65 + c4 + 3] = v[3];
        }
    }
    __syncthreads();
    {
        const int n = tid >> 3, kg = (tid & 7) * 8;
        float v[8];
#pragma unroll
        for (int j = 0; j < 8; ++j) v[j] = tile[(kg + j) * 65 + n];
        u32x4v o; o[0] = pk2(v[0], v[1]); o[1] = pk2(v[2], v[3]); o[2] = pk2(v[4], v[5]); o[3] = pk2(v[6], v[7]);
        *(u32x4v*)(dst + (size_t)(r0 + n) * K + k0 + kg) = o;
    }
    __syncthreads();
}

__device__ void phase_prep(const Params& p, unsigned char* shm) {
    const int tid = otid();
    u16* XB = (u16*)(p.ws + WS_XB);
    {
        const size_t n4 = (size_t)NTOK * DM / 4, half4 = n4 / 2;
        for (size_t i = (size_t)blockIdx.x * 512 + tid; i < n4; i += (size_t)gridDim.x * 512) {
            const f32x4v v = (i < half4) ? ((const f32x4v*)p.in[0])[i] : ((const f32x4v*)p.in[1])[i - half4];
            u32x2v o; o[0] = pk2(v[0], v[1]); o[1] = pk2(v[2], v[3]);
            ((u32x2v*)XB)[i] = o;
        }
    }
    if (blockIdx.x == 0 && tid < 64) {
        double* rope = (double*)(p.ws + WS_ROPE);
        rope[tid] = exp2(-(double)tid / 64.0 * 13.287712379549449) / 6.283185307179586;
    }
    if (blockIdx.x == 1) {
        float* om = (float*)(p.ws + WS_OMLB);
        for (int i = tid; i < 2048; i += 512) {
            const int jj = i >> 10, rest = i & 1023;
            float lb = 0.f;
            if (jj > 0) lb = sigmoidf_(p.in[16][1024 + rest] - p.in[16][rest]);
            om[i] = 1.0f - lb;
        }
    }
    const int T_FI = 88 * 16, T_FO = 16 * 44, T_EI = 60 * 16, T_OI = 72 * 16, T_SQ = 16 * 16;
    const int total = 8 * T_FI + 8 * T_FO + 2 * T_EI + 2 * T_OI + 4 * T_SQ;
    for (int u = blockIdx.x; u < total; u += gridDim.x) {
        int r = u;
        if (r < 8 * T_FI) {
            const int mi = r / T_FI, ti = r % T_FI, which = mi >> 2, l = mi & 3;
            const float* src = p.in[which ? 4 : 2] + (size_t)l * 1024 * 5632;
            u16* dst = (u16*)(p.ws + WS_FFN_IN + (size_t)mi * SZ_FFN_IN);
            const int rt = ti >> 4, kt = ti & 15;
            const int r0 = rt * 64, pn = r0 >> 8, hh = (r0 >> 7) & 1, jj = (r0 >> 6) & 1;
            transpose_tile(shm, src, 1024, 5632, dst, r0, hh * 2816 + pn * 128 + jj * 64, kt * 64);
            continue;
        }
        r -= 8 * T_FI;
        if (r < 8 * T_FO) {
            const int mi = r / T_FO, ti = r % T_FO, which = mi >> 2, l = mi & 3;
            const float* src = p.in[which ? 5 : 3] + (size_t)l * 2816 * 1024;
            u16* dst = (u16*)(p.ws + WS_FFN_OUT + (size_t)mi * SZ_FFN_OUT);
            const int rt = ti / 44, kt = ti % 44;
            transpose_tile(shm, src, 2816, 1024, dst, rt * 64, rt * 64, kt * 64);
            continue;
        }
        r -= 8 * T_FO;
        if (r < 2 * T_EI) {
            const int j = r / T_EI, ti = r % T_EI;
            const float* src = p.in[8] + (size_t)j * 1024 * 3632;
            u16* dst = (u16*)(p.ws + WS_EV_IN + (size_t)j * SZ_EV_IN);
            const int rt = ti >> 4, kt = ti & 15;
            transpose_tile(shm, src, 1024, 3632, dst, rt * 64, rt * 64, kt * 64);
            continue;
        }
        r -= 2 * T_EI;
        if (r < 2 * T_OI) {
            const int j = r / T_OI, ti = r % T_OI;
            const float* src = p.in[15] + (size_t)j * 1024 * 4608;
            u16* dst = (u16*)(p.ws + WS_OD_IN + (size_t)j * SZ_OD_IN);
            const int rt = ti >> 4, kt = ti & 15;
            transpose_tile(shm, src, 1024, 4608, dst, rt * 64, rt * 64, kt * 64);
            continue;
        }
        r -= 2 * T_OI;
        {
            const int mi = r / T_SQ, ti = r % T_SQ;
            const float* src = p.in[mi < 2 ? 14 : 18] + (size_t)(mi & 1) * 1024 * 1024;
            u16* dst = (u16*)(p.ws + (mi < 2 ? WS_EV_OUT : WS_OD_OUT) + (size_t)(mi & 1) * SZ_SQ);
            const int rt = ti >> 4, kt = ti & 15;
            transpose_tile(shm, src, 1024, 1024, dst, rt * 64, rt * 64, kt * 64);
        }
    }
}

__device__ void phase_ln(const Params& p, const float* g, const float* b, bool write_x) {
    const int tid = otid(); const int lane = tid & 63, w = tid >> 6;
    u16* XB = (u16*)(p.ws + WS_XB); float* STATS = (float*)(p.ws + WS_STATS);
    f32x4v gv[4], bv[4];
#pragma unroll
    for (int i = 0; i < 4; ++i) { gv[i] = *(const f32x4v*)(g + 4 * lane + 256 * i); bv[i] = *(const f32x4v*)(b + 4 * lane + 256 * i); }
    for (int row = blockIdx.x * 8 + w; row < NTOK; row += gridDim.x * 8) {
        float* xr = p.X + (size_t)row * DM;
        f32x4v v[4];
#pragma unroll
        for (int i = 0; i < 4; ++i) v[i] = *(const f32x4v*)(xr + 4 * lane + 256 * i);
        float s = 0.f;
#pragma unroll
        for (int i = 0; i < 4; ++i) s += v[i][0] + v[i][1] + v[i][2] + v[i][3];
#pragma unroll
        for (int o = 32; o >= 1; o >>= 1) s += __shfl_xor(s, o);
        const float mu = s * (1.0f / 1024.0f);
        float q = 0.f;
#pragma unroll
        for (int i = 0; i < 4; ++i)
#pragma unroll
            for (int j = 0; j < 4; ++j) { const float d = v[i][j] - mu; q += d * d; }
#pragma unroll
        for (int o = 32; o >= 1; o >>= 1) q += __shfl_xor(q, o);
        const float rs = rsqrtf(q * (1.0f / 1024.0f) + 1e-5f);
        if (lane == 0) { f32x2c st; st[0] = mu; st[1] = rs; *(f32x2c*)(STATS + 2 * (size_t)row) = st; }
#pragma unroll
        for (int i = 0; i < 4; ++i) {
            f32x4v o4;
#pragma unroll
            for (int j = 0; j < 4; ++j) o4[j] = (v[i][j] - mu) * rs * gv[i][j] + bv[i][j];
            if (write_x) *(f32x4v*)(xr + 4 * lane + 256 * i) = o4;
            u32x2v o2; o2[0] = pk2(o4[0], o4[1]); o2[1] = pk2(o4[2], o4[3]);
            *(u32x2v*)(XB + (size_t)row * DM + 4 * lane + 256 * i) = o2;
        }
    }
}

constexpr int QS = 136, VTS = 72, BS = 132, PS = 72;
constexpr int OFF_QN = 0;
constexpr int OFF_KN = OFF_QN + 64 * QS * 2;
constexpr int OFF_VT = OFF_KN + 64 * QS * 2;
constexpr int OFF_B = OFF_VT + 128 * VTS * 2;
constexpr int OFF_QS = OFF_B + 64 * BS * 4;
constexpr int OFF_KS = OFF_QS + 64 * QS * 2;
constexpr int OFF_QI = OFF_KS + 64 * QS * 2;
constexpr int OFF_P = OFF_QI + 64 * QS * 2;
constexpr int OFF_MISC = OFF_P + 64 * PS * 2;
constexpr int SCAN_LDS = OFF_MISC + 9216;
static_assert(SCAN_LDS <= 160 * 1024, "lds");
static_assert((OFF_B % 16) == 0 && (OFF_QS % 16) == 0 && (OFF_P % 16) == 0 && (OFF_MISC % 16) == 0, "align");

struct ScanCtx {
    const u16* Y; int ld;
    u16* H;
    u16* ST; float* DEC; float* NV;
    int cps;
    int even;
    int j;
    const float *gate_b, *conv_w, *a2_w, *a2_b, *norm_w, *lb_logits;
    const double* rope; const float* omlb;
};

__device__ __forceinline__ void unpack16(const u32x4v a, const u32x4v b, float* o) {
#pragma unroll
    for (int i = 0; i < 4; ++i) { o[2 * i] = __uint_as_float(a[i] << 16); o[2 * i + 1] = __uint_as_float(a[i] & 0xffff0000u);
                                  o[8 + 2 * i] = __uint_as_float(b[i] << 16); o[8 + 2 * i + 1] = __uint_as_float(b[i] & 0xffff0000u); }
}
__device__ __forceinline__ void put_v(u16* Vn, int t, int d0, const u32x4v a, const u32x4v b) {
    *(u32x4v*)(Vn + t * QS + d0) = a; *(u32x4v*)(Vn + t * QS + d0 + 8) = b;
}
template <int MODE, int MIX>
__device__ void scan_unit(const ScanCtx& cx, int c, int h, unsigned char* lds) {
    constexpr int dk = (MIX == 1) ? 64 : 128;
    constexpr bool scalar = (MIX == 0 || MIX == 3);
    constexpr int NKK = dk / 32;
    const int head = (MIX & 1) * 4 + h;
    const int tid = otid(), lane = tid & 63, w = tid >> 6;
    u16* Qn = (u16*)(lds + OFF_QN); u16* Kn = (u16*)(lds + OFF_KN); u16* VT = (u16*)(lds + OFF_VT); u16* Vg = (u16*)(lds + OFF_QI);
    float* Bm = (float*)(lds + OFF_B);
    u16* Qs = (u16*)(lds + OFF_QS); u16* Ks = (u16*)(lds + OFF_KS); u16* Qi = (u16*)(lds + OFF_QI); u16* Pm = (u16*)(lds + OFF_P);
    u16* Pb = Qs;
    float* GT = (float*)(lds + OFF_MISC);
    float* NPREV = GT + 256;
    float* DEN = NPREV + 256;
    float* SEG = DEN + 128;
    float* BFB = SEG + 512;
    const int t = tid >> 3, g = tid & 7, d0 = g * 16;
    const int cs = c % cx.cps;
    const size_t row0 = (size_t)c * 64;
    const int ld = cx.ld;
    const u16* Yr = cx.Y + (row0 + t) * ld;
    const int lr = lane & 15, lq = lane >> 4;
    const float lgam = __logf(1.0f - exp2f(-5.0f - (float)h));

    u32x4v rk[5][2], rq[5][2], rv[2], rg[2], rz[2][2], rba[4];
    float gr[4] = {0.f, 0.f, 0.f, 0.f}, nvp[2] = {0.f, 0.f};
    bf16x8 sb[2][NKK];
    if constexpr (MIX == 0) {
#pragma unroll
        for (int jt = 0; jt < 5; ++jt) {
            const int tt = cs * 64 + t + jt - 2;
            const bool ok = (tt >= 0 && tt < cx.cps * 64);
            const u16* src = cx.Y + (row0 + t + (ok ? jt - 2 : 0)) * ld + h * 128 + d0;
            rk[jt][0] = *(const u32x4v*)(src + 512); rk[jt][1] = *(const u32x4v*)(src + 512 + 8);
            if (!ok) { rk[jt][0] = (u32x4v){0u, 0u, 0u, 0u}; rk[jt][1] = (u32x4v){0u, 0u, 0u, 0u}; }
        }
        rv[0] = *(const u32x4v*)(Yr + 1024 + h * 128 + d0); rv[1] = *(const u32x4v*)(Yr + 1024 + h * 128 + d0 + 8);
        if (tid < 64) { const u16* yr = cx.Y + (row0 + tid) * ld + 2048;
#pragma unroll
            for (int i = 0; i < 4; ++i) gr[i] = bf2f(yr[4 * i + h]); }
        if (MODE == 1) { rg[0] = *(const u32x4v*)(Yr + 1536 + h * 128 + d0); rg[1] = *(const u32x4v*)(Yr + 1536 + h * 128 + d0 + 8);
            if (tid < 128) { nvp[0] = cx.NV[((size_t)c * 8 + h * 2 + 0) * 128 + tid]; nvp[1] = cx.NV[((size_t)c * 8 + h * 2 + 1) * 128 + tid]; } }
    } else if constexpr (MIX == 1) {
        if (g < 4) { if (MODE == 1) { rq[0][0] = *(const u32x4v*)(Yr + 2064 + h * 64 + d0); rq[0][1] = *(const u32x4v*)(Yr + 2064 + h * 64 + d0 + 8); } }
        else { rk[0][0] = *(const u32x4v*)(Yr + 2320 + h * 64 + d0 - 64); rk[0][1] = *(const u32x4v*)(Yr + 2320 + h * 64 + d0 - 64 + 8); }
        rv[0] = *(const u32x4v*)(Yr + 2576 + h * 128 + d0); rv[1] = *(const u32x4v*)(Yr + 2576 + h * 128 + d0 + 8);
#pragma unroll
        for (int i = 0; i < 4; ++i) rba[i] = *(const u32x4v*)(Yr + 3600 + 8 * i);
        if (MODE == 1) { rg[0] = *(const u32x4v*)(Yr + 3088 + h * 128 + d0); rg[1] = *(const u32x4v*)(Yr + 3088 + h * 128 + d0 + 8); }
    } else if constexpr (MIX == 2) {
        if (MODE == 1) { rq[0][0] = *(const u32x4v*)(Yr + h * 128 + d0); rq[0][1] = *(const u32x4v*)(Yr + h * 128 + d0 + 8); }
        rv[0] = *(const u32x4v*)(Yr + 1536 + h * 128 + d0); rv[1] = *(const u32x4v*)(Yr + 1536 + h * 128 + d0 + 8);
#pragma unroll
        for (int dd = 0; dd < 2; ++dd) { rz[dd][0] = *(const u32x4v*)(Yr + 512 + dd * 512 + h * 128 + d0); rz[dd][1] = *(const u32x4v*)(Yr + 512 + dd * 512 + h * 128 + d0 + 8); }
        if (MODE == 1) { rg[0] = *(const u32x4v*)(Yr + 2048 + h * 128 + d0); rg[1] = *(const u32x4v*)(Yr + 2048 + h * 128 + d0 + 8); }
    } else {
        const int gg = g & 3, isk = g >> 2;
        if (MODE == 1 || isk) { const u16* src = Yr + (isk ? 3072 : 2560) + h * 128 + gg * 16;
            rq[0][0] = *(const u32x4v*)src; rq[0][1] = *(const u32x4v*)(src + 8); rq[1][0] = *(const u32x4v*)(src + 64); rq[1][1] = *(const u32x4v*)(src + 72); }
        rv[0] = *(const u32x4v*)(Yr + 3584 + h * 128 + d0); rv[1] = *(const u32x4v*)(Yr + 3584 + h * 128 + d0 + 8);
        if (MODE == 1) { rg[0] = *(const u32x4v*)(Yr + 4096 + h * 128 + d0); rg[1] = *(const u32x4v*)(Yr + 4096 + h * 128 + d0 + 8); }
    }
    if (MODE == 1) {
#pragma unroll
        for (int dd = 0; dd < 2; ++dd)
#pragma unroll
            for (int kk = 0; kk < NKK; ++kk) sb[dd][kk] = *(const bf16x8*)(cx.ST + ((size_t)c * 16 + head * 2 + dd) * 16384 + (16 * w + lr) * 128 + 32 * kk + 8 * lq);
    }

    if constexpr (MIX == 0) {
#pragma unroll 1
        for (int which = 1; which >= (MODE == 0 ? 1 : 0); --which) {
            const int ch0 = which * 512 + h * 128 + d0;
            if (which == 0) {
#pragma unroll
                for (int jt = 0; jt < 5; ++jt) {
                    const int tt = cs * 64 + t + jt - 2;
                    const bool ok = (tt >= 0 && tt < cx.cps * 64);
                    const u16* src = cx.Y + (row0 + t + (ok ? jt - 2 : 0)) * ld + h * 128 + d0;
                    rk[jt][0] = *(const u32x4v*)src; rk[jt][1] = *(const u32x4v*)(src + 8);
                    if (!ok) { rk[jt][0] = (u32x4v){0u, 0u, 0u, 0u}; rk[jt][1] = (u32x4v){0u, 0u, 0u, 0u}; }
                }
            }
            float acc[16];
#pragma unroll
            for (int i = 0; i < 16; ++i) acc[i] = 0.f;
#pragma unroll
            for (int jt = 0; jt < 5; ++jt) {
                float xv[16];
                unpack16(rk[jt][0], rk[jt][1], xv);
                const f32x4v* wj = (const f32x4v*)(cx.conv_w + jt * 1024 + ch0);
#pragma unroll
                for (int q4 = 0; q4 < 4; ++q4) { const f32x4v wv = wj[q4];
#pragma unroll
                    for (int jx = 0; jx < 4; ++jx) acc[4 * q4 + jx] += xv[4 * q4 + jx] * wv[jx]; }
            }
            const float sc = which ? 0.08838834764831845f : 1.0f;
#pragma unroll
            for (int i = 0; i < 16; ++i) acc[i] = acc[i] * sc * __builtin_amdgcn_rcpf(1.0f + __expf(-acc[i]));
            store16((which ? Kn : Qn) + t * QS + d0, acc);
        }
        put_v(Vg, t, d0, rv[0], rv[1]);
        if (tid < 64) {
            GT[0 * 64 + tid] = gr[0] + cx.gate_b[0 + h]; GT[1 * 64 + tid] = logsigf_(gr[1] + cx.gate_b[4 + h]);
            GT[2 * 64 + tid] = gr[2] + cx.gate_b[8 + h]; GT[3 * 64 + tid] = logsigf_(gr[3] + cx.gate_b[12 + h]);
        }
        if (MODE == 1 && tid < 128) { NPREV[tid] = nvp[0]; NPREV[128 + tid] = nvp[1]; }
    } else if constexpr (MIX == 1) {
        if (g < 4) {
            if (MODE == 1) { float xv[16]; unpack16(rq[0][0], rq[0][1], xv);
#pragma unroll
                for (int i = 0; i < 16; ++i) xv[i] *= 0.125f;
                store16(Qn + t * QS + d0, xv); }
        } else { *(u32x4v*)(Kn + t * QS + (d0 - 64)) = rk[0][0]; *(u32x4v*)(Kn + t * QS + (d0 - 64) + 8) = rk[0][1]; }
        put_v(Vg, t, d0, rv[0], rv[1]);
    } else if constexpr (MIX == 2) {
        if (MODE == 1) { float xv[16]; unpack16(rq[0][0], rq[0][1], xv);
#pragma unroll
            for (int i = 0; i < 16; ++i) xv[i] = xv[i] * 0.08838834764831845f * __builtin_amdgcn_rcpf(1.0f + __expf(-xv[i]));
            store16(Qn + t * QS + d0, xv); }
        put_v(Vg, t, d0, rv[0], rv[1]);
    } else {
        const int gg = g & 3, isk = g >> 2;
        if (MODE == 1 || isk) {
            float x1[16], x2[16], o1[16], o2[16];
            unpack16(rq[0][0], rq[0][1], x1); unpack16(rq[1][0], rq[1][1], x2);
            const double pos = (double)(cs * 64 + t);
            const float sc = isk ? 0.08838834764831845f : 1.0f;
#pragma unroll
            for (int i = 0; i < 16; ++i) {
                const double tr = pos * cx.rope[gg * 16 + i];
                const float fr = (float)(tr - rint(tr));
                const float sn = __builtin_amdgcn_sinf(fr) * sc, cn = __builtin_amdgcn_cosf(fr) * sc;
                o1[i] = x1[i] * cn - x2[i] * sn; o2[i] = x1[i] * sn + x2[i] * cn;
            }
            u16* dstp = (isk ? Kn : Qn) + t * QS;
            store16(dstp + gg * 16, o1); store16(dstp + 64 + gg * 16, o2);
        }
        put_v(Vg, t, d0, rv[0], rv[1]);
    }
    __syncthreads();
    {
        const u32x4v a = *(const u32x4v*)(Vg + lane * QS + 16 * w), b = *(const u32x4v*)(Vg + lane * QS + 16 * w + 8);
#pragma unroll
        for (int i = 0; i < 4; ++i) {
            VT[(16 * w + 2 * i) * VTS + lane] = (u16)(a[i] & 0xffffu); VT[(16 * w + 2 * i + 1) * VTS + lane] = (u16)(a[i] >> 16);
            VT[(16 * w + 8 + 2 * i) * VTS + lane] = (u16)(b[i] & 0xffffu); VT[(16 * w + 8 + 2 * i + 1) * VTS + lane] = (u16)(b[i] >> 16);
        }
    }

    f32x4 acc_tot[4];
#pragma unroll
    for (int i = 0; i < 4; ++i) acc_tot[i] = (f32x4){0.f, 0.f, 0.f, 0.f};

    if constexpr (scalar && MODE == 1) {
        if constexpr (MIX == 0) {
            if (w < 2) {
                float v = GT[(1 + 2 * w) * 64 + lane];
                if (w == 0) {
#pragma unroll
                    for (int o = 1; o < 64; o <<= 1) { const float n = __shfl_up(v, o); if (lane >= o) v += n; }
                } else {
#pragma unroll
                    for (int o = 1; o < 64; o <<= 1) { const float n = __shfl_down(v, o); if (lane + o < 64) v += n; }
                }
                BFB[w * 64 + lane] = v;
            }
        } else {
            if (tid < 128) { const int dd = tid >> 6, tt = tid & 63; BFB[tid] = lgam * (float)(dd ? (64 - tt) : (tt + 1)); }
        }
        __syncthreads();
        {
            const int ti = w >> 1, tj0 = 2 * (w & 1);
            f32x4 sc[2] = {(f32x4){0.f, 0.f, 0.f, 0.f}, (f32x4){0.f, 0.f, 0.f, 0.f}};
#pragma unroll
            for (int kk = 0; kk < NKK; ++kk) {
                const bf16x8 af = *(const bf16x8*)(Qn + (16 * ti + lr) * QS + 32 * kk + 8 * lq);
#pragma unroll
                for (int jj = 0; jj < 2; ++jj) {
                    const bf16x8 bfr = *(const bf16x8*)(Kn + (16 * (tj0 + jj) + lr) * QS + 32 * kk + 8 * lq);
                    sc[jj] = __builtin_amdgcn_mfma_f32_16x16x32_bf16(af, bfr, sc[jj], 0, 0, 0);
                }
            }
#pragma unroll
            for (int dd = 0; dd < 2; ++dd) {
                u16* Pd = dd ? Pb : Pm;
#pragma unroll
                for (int jj = 0; jj < 2; ++jj) {
                    const int ss = 16 * (tj0 + jj) + lr;
                    const float bs = BFB[dd * 64 + ss] - ((MIX == 0) ? GT[(2 * dd) * 64 + ss] : 0.f);
#pragma unroll
                    for (int r = 0; r < 4; ++r) {
                        const int tt = 16 * ti + 4 * lq + r;
                        const bool keep = dd ? (ss >= tt) : (ss <= tt);
                        const float wgt = __expf(fminf(BFB[dd * 64 + tt] - bs, 60.f));
                        Pd[tt * PS + ss] = (u16)(pk2(keep ? sc[jj][r] * wgt : 0.f, 0.f) & 0xffffu);
                    }
                }
            }
        }
        __syncthreads();
        if constexpr (MIX == 0) {
            float pf[16], pbv[16], qv[16];
            const u32x4v p0 = *(const u32x4v*)(Pm + t * PS + 8 * g), p1 = *(const u32x4v*)(Pb + t * PS + 8 * g);
            unpack16(p0, p0, pf); unpack16(p1, p1, pbv);
            unpack16(*(const u32x4v*)(Qn + t * QS + d0), *(const u32x4v*)(Qn + t * QS + d0 + 8), qv);
            float vf = 0.f, vb2 = 0.f, qf = 0.f, qb = 0.f;
#pragma unroll
            for (int i = 0; i < 8; ++i) { vf += pf[i]; vb2 += pbv[i]; }
#pragma unroll
            for (int i = 0; i < 16; ++i) { qf += qv[i] * NPREV[d0 + i]; qb += qv[i] * NPREV[128 + d0 + i]; }
            vf += __expf(BFB[t]) * qf; vb2 += __expf(BFB[64 + t]) * qb;
            vf += __shfl_xor(vf, 1); vb2 += __shfl_xor(vb2, 1); vf += __shfl_xor(vf, 2); vb2 += __shfl_xor(vb2, 2); vf += __shfl_xor(vf, 4); vb2 += __shfl_xor(vb2, 4);
            if (g == 0) { DEN[t] = vf; DEN[64 + t] = vb2; }
            __syncthreads();
        }
#pragma unroll
        for (int dd = 0; dd < 2; ++dd) {
            const u16* Pd = dd ? Pb : Pm;
            f32x4 ad[4], ai[4];
#pragma unroll
            for (int i = 0; i < 4; ++i) { ad[i] = (f32x4){0.f, 0.f, 0.f, 0.f}; ai[i] = (f32x4){0.f, 0.f, 0.f, 0.f}; }
#pragma unroll
            for (int kk = 0; kk < 2; ++kk) {
                const bf16x8 vb = *(const bf16x8*)(VT + (16 * w + lr) * VTS + 32 * kk + 8 * lq);
#pragma unroll
                for (int ti = 0; ti < 4; ++ti) {
                    const bf16x8 af = *(const bf16x8*)(Pd + (16 * ti + lr) * PS + 32 * kk + 8 * lq);
                    ad[ti] = __builtin_amdgcn_mfma_f32_16x16x32_bf16(af, vb, ad[ti], 0, 0, 0);
                }
            }
#pragma unroll
            for (int kk = 0; kk < NKK; ++kk)
#pragma unroll
                for (int ti = 0; ti < 4; ++ti) {
                    const bf16x8 af = *(const bf16x8*)(Qn + (16 * ti + lr) * QS + 32 * kk + 8 * lq);
                    ai[ti] = __builtin_amdgcn_mfma_f32_16x16x32_bf16(af, sb[dd][kk], ai[ti], 0, 0, 0);
                }
#pragma unroll
            for (int ti = 0; ti < 4; ++ti)
#pragma unroll
                for (int r = 0; r < 4; ++r) {
                    const int tt = 16 * ti + 4 * lq + r;
                    float v = ad[ti][r] + __expf(BFB[dd * 64 + tt]) * ai[ti][r];
                    if (MIX == 0) v *= __builtin_amdgcn_rcpf(fmaxf(fabsf(DEN[dd * 64 + tt]), 1.0f));
                    acc_tot[ti][r] += v;
                }
        }
        __syncthreads();
    } else {
#pragma unroll 1
    for (int dir = 0; dir < 2; ++dir) {
        if constexpr (MIX == 1) {
            const int dd0 = g * 8;
            float ba[16];
            if (dir == 0) unpack16(rba[0], rba[1], ba); else unpack16(rba[2], rba[3], ba);
            const float* w2 = cx.a2_w + (size_t)dir * 16 * 256 + h * 64 + dd0;
            const float* b2 = cx.a2_b + dir * 256 + h * 64 + dd0;
            f32x4v a0 = *(const f32x4v*)b2, a1 = *(const f32x4v*)(b2 + 4);
#pragma unroll
            for (int r = 0; r < 16; ++r) { const f32x4v w0 = *(const f32x4v*)(w2 + r * 256), w1 = *(const f32x4v*)(w2 + r * 256 + 4); a0 += ba[r] * w0; a1 += ba[r] * w1; }
            f32x4v o0, o1;
#pragma unroll
            for (int i = 0; i < 4; ++i) { o0[i] = logsigf_(a0[i]) * 0.0625f; o1[i] = logsigf_(a1[i]) * 0.0625f; }
            *(f32x4v*)(Bm + t * BS + dd0) = o0; *(f32x4v*)(Bm + t * BS + dd0 + 4) = o1;
        } else if constexpr (MIX == 2) {
            float z[16], kk[16];
            if (dir == 0) unpack16(rz[0][0], rz[0][1], z); else unpack16(rz[1][0], rz[1][1], z);
            const f32x4v* om = (const f32x4v*)(cx.omlb + (cx.j * 2 + dir) * 512 + h * 128 + d0);
#pragma unroll
            for (int q4 = 0; q4 < 4; ++q4) {
                const f32x4v ov = om[q4]; f32x4v lo;
#pragma unroll
                for (int jx = 0; jx < 4; ++jx) {
                    const float E = __expf(fminf(-z[4 * q4 + jx], 80.f)), r = __builtin_amdgcn_rcpf(1.0f + E), ol = ov[jx];
                    lo[jx] = __logf(fmaxf((1.0f - ol) + ol * r, 1e-30f));
                    kk[4 * q4 + jx] = ol * E * r;
                }
                *(f32x4v*)(Bm + t * BS + d0 + 4 * q4) = lo;
            }
            store16(Kn + t * QS + d0, kk);
        }
        if constexpr (!scalar) __syncthreads();
        if constexpr (scalar) {
            if (w == 0) {
                float v = (MIX == 0) ? GT[(1 + 2 * dir) * 64 + lane] : lgam;
                if (dir == 0) {
#pragma unroll
                    for (int o = 1; o < 64; o <<= 1) { const float n = __shfl_up(v, o); if (lane >= o) v += n; }
                } else {
#pragma unroll
                    for (int o = 1; o < 64; o <<= 1) { const float n = __shfl_down(v, o); if (lane + o < 64) v += n; }
                }
                Bm[lane * BS] = v;
            }
        } else {
            const int d = tid & 127, sg = tid >> 7;
            if (d < dk) {
                float run = 0.f;
                if (dir == 0) {
#pragma unroll
                    for (int i = 0; i < 16; ++i) { const int tt = sg * 16 + i; run += Bm[tt * BS + d]; Bm[tt * BS + d] = run; } }
                else {
#pragma unroll
                    for (int i = 15; i >= 0; --i) { const int tt = sg * 16 + i; run += Bm[tt * BS + d]; Bm[tt * BS + d] = run; } }
                SEG[sg * 128 + d] = run;
            }
            __syncthreads();
            if (d < dk) {
                float off = 0.f;
                if (dir == 0) { for (int s2 = 0; s2 < sg; ++s2) off += SEG[s2 * 128 + d]; }
                else { for (int s2 = 3; s2 > sg; --s2) off += SEG[s2 * 128 + d]; }
#pragma unroll
                for (int i = 0; i < 16; ++i) Bm[(sg * 16 + i) * BS + d] += off;
            }
        }
        __syncthreads();

        const int tend = dir ? 0 : 63;
        const size_t slot = (size_t)c * 16 + head * 2 + dir;
        const float li = (MIX == 0) ? GT[(2 * dir) * 64 + t] : 0.f;
        if (MODE == 0) {
            u16* KT = Qs;
            if (16 * w < dk) {
                float kv[16]; unpack16(*(const u32x4v*)(Kn + lane * QS + 16 * w), *(const u32x4v*)(Kn + lane * QS + 16 * w + 8), kv);
                const float lis = (MIX == 0) ? GT[(2 * dir) * 64 + lane] : 0.f;
                if (scalar) {
                    const float e = expc(Bm[tend * BS] - Bm[lane * BS] + lis);
#pragma unroll
                    for (int i = 0; i < 16; ++i) kv[i] *= e;
                } else {
#pragma unroll
                    for (int q4 = 0; q4 < 4; ++q4) { const f32x4v be = *(const f32x4v*)(Bm + tend * BS + 16 * w + 4 * q4), bt = *(const f32x4v*)(Bm + lane * BS + 16 * w + 4 * q4);
#pragma unroll
                        for (int jx = 0; jx < 4; ++jx) kv[4 * q4 + jx] *= expc(be[jx] - bt[jx]); }
                }
#pragma unroll
                for (int i = 0; i < 8; ++i) { const unsigned pkd = pk2(kv[2 * i], kv[2 * i + 1]);
                    KT[(16 * w + 2 * i) * VTS + lane] = (u16)(pkd & 0xffffu); KT[(16 * w + 2 * i + 1) * VTS + lane] = (u16)(pkd >> 16); }
            }
            if (tid < 128) cx.DEC[slot * 128 + tid] = __expf(Bm[tend * BS + (scalar ? 0 : (tid < dk ? tid : 0))]);
            __syncthreads();
            if (MIX == 0 && tid < 128) {
                float s = 0.f;
#pragma unroll
                for (int q8 = 0; q8 < 8; ++q8) { float xv[16]; const u32x4v r = *(const u32x4v*)(KT + tid * VTS + 8 * q8); unpack16(r, r, xv);
#pragma unroll
                    for (int i = 0; i < 8; ++i) s += xv[i]; }
                cx.NV[((size_t)c * 8 + h * 2 + dir) * 128 + tid] = s;
            }
            bf16x8 vb[2];
#pragma unroll
            for (int kk = 0; kk < 2; ++kk) vb[kk] = *(const bf16x8*)(VT + (16 * w + lr) * VTS + 32 * kk + 8 * lq);
            u16* Sd = cx.ST + slot * 16384;
#pragma unroll 2
            for (int di = 0; di < dk / 16; ++di) {
                f32x4 a4 = (f32x4){0.f, 0.f, 0.f, 0.f};
#pragma unroll
                for (int kk = 0; kk < 2; ++kk) {
                    const bf16x8 af = *(const bf16x8*)(KT + (16 * di + lr) * VTS + 32 * kk + 8 * lq);
                    a4 = __builtin_amdgcn_mfma_f32_16x16x32_bf16(af, vb[kk], a4, 0, 0, 0);
                }
                u32x2v o; o[0] = pk2(a4[0], a4[1]); o[1] = pk2(a4[2], a4[3]);
                *(u32x2v*)(Sd + (16 * w + lr) * 128 + 16 * di + 4 * lq) = o;
            }
            __syncthreads();
        } else {
            const int tmid = 32;
            if (d0 < dk) {
                float qv[16], kv[16], a[16], bb[16], cc[16];
                unpack16(*(const u32x4v*)(Qn + t * QS + d0), *(const u32x4v*)(Qn + t * QS + d0 + 8), qv);
                unpack16(*(const u32x4v*)(Kn + t * QS + d0), *(const u32x4v*)(Kn + t * QS + d0 + 8), kv);
#pragma unroll
                for (int q4 = 0; q4 < 4; ++q4) { const f32x4v bmv = *(const f32x4v*)(Bm + tmid * BS + d0 + 4 * q4), bt = *(const f32x4v*)(Bm + t * BS + d0 + 4 * q4);
#pragma unroll
                    for (int jx = 0; jx < 4; ++jx) { const int i = 4 * q4 + jx; const float df = bt[jx] - bmv[jx];
                        a[i] = qv[i] * expc(df); bb[i] = kv[i] * expc(-df); cc[i] = qv[i] * __expf(bt[jx]); } }
                store16(Qs + t * QS + d0, a); store16(Ks + t * QS + d0, bb); store16(Qi + t * QS + d0, cc);
            }
            __syncthreads();
            {
                const int ti = w >> 1, tj0 = 2 * (w & 1);
                f32x4 sc[2] = {(f32x4){0.f, 0.f, 0.f, 0.f}, (f32x4){0.f, 0.f, 0.f, 0.f}};
#pragma unroll
                for (int kk = 0; kk < NKK; ++kk) {
                    const bf16x8 af = *(const bf16x8*)(Qs + (16 * ti + lr) * QS + 32 * kk + 8 * lq);
#pragma unroll
                    for (int jj = 0; jj < 2; ++jj) {
                        const bf16x8 bfr = *(const bf16x8*)(Ks + (16 * (tj0 + jj) + lr) * QS + 32 * kk + 8 * lq);
                        sc[jj] = __builtin_amdgcn_mfma_f32_16x16x32_bf16(af, bfr, sc[jj], 0, 0, 0);
                    }
                }
#pragma unroll
                for (int jj = 0; jj < 2; ++jj)
#pragma unroll
                    for (int r = 0; r < 4; ++r) {
                        const int tt = 16 * ti + 4 * lq + r, ss = 16 * (tj0 + jj) + lr;
                        const bool keep = dir ? (ss >= tt) : (ss <= tt);
                        Pm[tt * PS + ss] = (u16)(pk2(keep ? sc[jj][r] : 0.f, 0.f) & 0xffffu);
                    }
            }
            __syncthreads();
            f32x4 ad[4];
#pragma unroll
            for (int i = 0; i < 4; ++i) ad[i] = (f32x4){0.f, 0.f, 0.f, 0.f};
#pragma unroll
            for (int kk = 0; kk < 2; ++kk) {
                const bf16x8 vb = *(const bf16x8*)(VT + (16 * w + lr) * VTS + 32 * kk + 8 * lq);
#pragma unroll
                for (int ti = 0; ti < 4; ++ti) {
                    const bf16x8 af = *(const bf16x8*)(Pm + (16 * ti + lr) * PS + 32 * kk + 8 * lq);
                    ad[ti] = __builtin_amdgcn_mfma_f32_16x16x32_bf16(af, vb, ad[ti], 0, 0, 0);
                }
            }
#pragma unroll
            for (int kk = 0; kk < NKK; ++kk)
#pragma unroll
                for (int ti = 0; ti < 4; ++ti) {
                    const bf16x8 af = *(const bf16x8*)(Qi + (16 * ti + lr) * QS + 32 * kk + 8 * lq);
                    ad[ti] = __builtin_amdgcn_mfma_f32_16x16x32_bf16(af, dir ? sb[1][kk] : sb[0][kk], ad[ti], 0, 0, 0);
                }
#pragma unroll
            for (int ti = 0; ti < 4; ++ti) acc_tot[ti] += ad[ti];
            __syncthreads();
        }
    }
    }

    if (MODE == 1) {
        float* Ot = Bm;
#pragma unroll
        for (int ti = 0; ti < 4; ++ti)
#pragma unroll
            for (int r = 0; r < 4; ++r) Ot[(16 * ti + 4 * lq + r) * BS + 16 * w + lr] = acc_tot[ti][r];
        __syncthreads();
        float ov[16];
#pragma unroll
        for (int q4 = 0; q4 < 4; ++q4) { const f32x4v x = *(const f32x4v*)(Ot + t * BS + d0 + 4 * q4); ov[4 * q4] = x[0]; ov[4 * q4 + 1] = x[1]; ov[4 * q4 + 2] = x[2]; ov[4 * q4 + 3] = x[3]; }
        float s1 = 0.f, s2 = 0.f;
#pragma unroll
        for (int i = 0; i < 16; ++i) { s1 += ov[i]; s2 += ov[i] * ov[i]; }
        s1 += __shfl_xor(s1, 1); s2 += __shfl_xor(s2, 1); s1 += __shfl_xor(s1, 2); s2 += __shfl_xor(s2, 2); s1 += __shfl_xor(s1, 4); s2 += __shfl_xor(s2, 4);
        constexpr bool lnorm = (MIX == 0 || MIX == 3);
        const float mean_ = s1 * (1.f / 128.f), ex2 = s2 * (1.f / 128.f);
        const float mu = lnorm ? mean_ : 0.f;
        const float rs = rsqrtf((lnorm ? fmaxf(ex2 - mean_ * mean_, 0.f) : ex2) + 1e-5f);
        const int hcol = ((MIX & 1) ? 512 : 0) + h * 128 + d0;
        float gv[16]; unpack16(rg[0], rg[1], gv);
        float nw[16];
        if constexpr (MIX != 3) {
            const float* nwp = cx.norm_w + hcol;
#pragma unroll
            for (int q4 = 0; q4 < 4; ++q4) { const f32x4v x = *(const f32x4v*)(nwp + 4 * q4); nw[4 * q4] = x[0]; nw[4 * q4 + 1] = x[1]; nw[4 * q4 + 2] = x[2]; nw[4 * q4 + 3] = x[3]; }
        } else {
#pragma unroll
            for (int i = 0; i < 16; ++i) nw[i] = 1.f;
        }
#pragma unroll
        for (int i = 0; i < 16; ++i) {
            const float sg = __builtin_amdgcn_rcpf(1.0f + __expf(-gv[i]));
            const float gate = (MIX == 0) ? sg : gv[i] * sg;
            ov[i] = (ov[i] - mu) * rs * nw[i] * gate;
        }
        store16(cx.H + (row0 + t) * DM + hcol, ov);
        __syncthreads();
    }
}

template <int MODE>
__device__ __forceinline__ void phase_scan(const ScanCtx& cx, unsigned char* shm) {
    const int b = obid();
    if (cx.even) {
#pragma unroll 1
        for (int v = b; v < 1024; v += gridDim.x) scan_unit<MODE, 0>(cx, v >> 2, v & 3, shm);
#pragma unroll 1
        for (int v = b; v < 1024; v += gridDim.x) scan_unit<MODE, 1>(cx, v >> 2, v & 3, shm);
    } else {
#pragma unroll 1
        for (int v = b; v < 1024; v += gridDim.x) scan_unit<MODE, 2>(cx, v >> 2, v & 3, shm);
#pragma unroll 1
        for (int v = b; v < 1024; v += gridDim.x) scan_unit<MODE, 3>(cx, v >> 2, v & 3, shm);
    }
}

__device__ void phase_scan_prefix(const ScanCtx& cx, bool dry) {
    const int tid = otid();
    const int nseq = 256 / cx.cps;
    const int nunits = nseq * 16 * 16;
    for (int u = blockIdx.x; u < nunits; u += gridDim.x) {
        const int chain = u >> 4, sub = u & 15;
        const int seq = chain >> 4, hd = chain & 15, head = hd >> 1, dir = hd & 1;
        const int idx = sub * 512 + tid, e = idx >> 6, d = (idx & 63) * 2;
        const int dk = (cx.even && head >= 4) ? 64 : 128;
        const int cbase = seq * cx.cps, n = cx.cps;
        if (d < dk) {
            float s0 = 0.f, s1 = 0.f;
#pragma unroll 1
            for (int i0 = 0; i0 < n; i0 += 32) {
                unsigned wv[32]; f32x2c dc[32];
#pragma unroll
                for (int k = 0; k < 32; ++k) {
                    const int c = dir ? (cbase + n - 1 - (i0 + k)) : (cbase + i0 + k);
                    const size_t slot = (size_t)c * 16 + hd;
                    wv[k] = *(const unsigned*)(cx.ST + slot * 16384 + e * 128 + d);
                    dc[k] = *(const f32x2c*)(cx.DEC + slot * 128 + d);
                }
#pragma unroll
                for (int k = 0; k < 32; ++k) {
                    const int c = dir ? (cbase + n - 1 - (i0 + k)) : (cbase + i0 + k);
                    const size_t slot = (size_t)c * 16 + hd;
                    *(unsigned*)(cx.ST + slot * 16384 + e * 128 + d) = dry ? wv[k] : pk2(s0, s1);
                    s0 = dc[k][0] * s0 + __uint_as_float(wv[k] << 16);
                    s1 = dc[k][1] * s1 + __uint_as_float(wv[k] & 0xffff0000u);
                }
            }
        }
        if (cx.even && head < 4 && sub == 0 && tid < 128) {
            float s = 0.f;
#pragma unroll 1
            for (int i0 = 0; i0 < n; i0 += 8) {
                float dl[8], dc[8];
#pragma unroll
                for (int k = 0; k < 8; ++k) {
                    const int c = dir ? (cbase + n - 1 - (i0 + k)) : (cbase + i0 + k);
                    dl[k] = cx.NV[((size_t)c * 8 + head * 2 + dir) * 128 + tid];
                    dc[k] = cx.DEC[((size_t)c * 16 + hd) * 128 + tid];
                }
#pragma unroll
                for (int k = 0; k < 8; ++k) {
                    const int c = dir ? (cbase + n - 1 - (i0 + k)) : (cbase + i0 + k);
                    cx.NV[((size_t)c * 8 + head * 2 + dir) * 128 + tid] = dry ? dl[k] : s;
                    s = dc[k] * s + dl[k];
                }
            }
        }
    }
}

constexpr int PH_PER_LAYER = 31, N_PHASES = 1 + 4 * PH_PER_LAYER;

__device__ void run_phase(const Params& p, int ph, unsigned char* shm, bool dry) {
    if (ph == 0) { phase_prep(p, shm); return; }
    const int l = (ph - 1) / PH_PER_LAYER, s = (ph - 1) % PH_PER_LAYER, j = l >> 1, even = !(l & 1);
    u16* XB = (u16*)(p.ws + WS_XB);
    if (s < 5 || s >= 26) {
        const int which = (s >= 26), ss = which ? s - 26 : s;
        if (ss == 4) { phase_ln(p, p.in[6] + (l * 3 + (which ? 2 : 0)) * DM, p.in[7] + (l * 3 + (which ? 2 : 0)) * DM, which && l == 3); return; }
        const int half = ss >> 1;
        u16* ACT = (u16*)(p.ws + WS_ACT);
        if ((ss & 1) == 0) {
            EpiSwiGLU E; E.O = ACT; E.ldc = DFF;
            run_gemm(shm, XB + (size_t)half * HALF_ROWS * DM, (const u16*)(p.ws + WS_FFN_IN + (size_t)(which * 4 + l) * SZ_FFN_IN), HALF_ROWS, 5632, 1024, E);
        } else {
            EpiResid E; E.X = p.X + (size_t)half * HALF_ROWS * DM; E.src = E.X; E.scale = 0.5f; E.dry = dry;
            const int lnidx = which ? (l * 3 + 1) : (l * 3 - 1);
            if (lnidx < 0) { E.stats = nullptr; E.g = nullptr; E.b = nullptr; E.src = p.in[half]; }
            else { E.stats = (const float*)(p.ws + WS_STATS) + 2 * (size_t)half * HALF_ROWS; E.g = p.in[6] + lnidx * DM; E.b = p.in[7] + lnidx * DM; }
            run_gemm(shm, ACT, (const u16*)(p.ws + WS_FFN_OUT + (size_t)(which * 4 + l) * SZ_FFN_OUT), HALF_ROWS, 1024, DFF, E);
        }
        return;
    }
    if (s == 25) { phase_ln(p, p.in[6] + (l * 3 + 1) * DM, p.in[7] + (l * 3 + 1) * DM, false); return; }
    const int q = (s - 5) / 5, k = (s - 5) % 5;
    ScanCtx cx;
    cx.Y = (const u16*)(p.ws + WS_Y); cx.ld = even ? EVC : ODC;
    cx.H = XB + (size_t)q * Q_ROWS * DM;
    cx.ST = (u16*)(p.ws + WS_ST); cx.DEC = (float*)(p.ws + WS_DEC); cx.NV = (float*)(p.ws + WS_NV);
    cx.cps = (q < 2) ? 256 : 64; cx.even = even; cx.j = j;
    cx.gate_b = p.in[9] + j * 16; cx.conv_w = p.in[10] + j * 5 * 1024; cx.a2_w = p.in[11] + (size_t)j * 2 * 16 * 256; cx.a2_b = p.in[12] + j * 2 * 256;
    cx.norm_w = even ? (p.in[13] + j * 1024) : (p.in[17] + j * 512);
    cx.lb_logits = p.in[16];
    cx.rope = (const double*)(p.ws + WS_ROPE); cx.omlb = (const float*)(p.ws + WS_OMLB);
    if (k == 0) {
        EpiBf16 E; E.O = (u16*)(p.ws + WS_Y); E.ldc = cx.ld;
        const u16* Bt = even ? (const u16*)(p.ws + WS_EV_IN + (size_t)j * SZ_EV_IN) : (const u16*)(p.ws + WS_OD_IN + (size_t)j * SZ_OD_IN);
        run_gemm(shm, XB + (size_t)q * Q_ROWS * DM, Bt, Q_ROWS, cx.ld, 1024, E);
    } else if (k == 1) {
        phase_scan<0>(cx, shm);
    } else if (k == 2) {
        phase_scan_prefix(cx, dry);
    } else if (k == 3) {
        phase_scan<1>(cx, shm);
    } else {
        EpiResid E; E.X = p.X; E.src = E.X; E.scale = 1.0f; E.dry = dry;
        E.stats = (const float*)(p.ws + WS_STATS); E.g = p.in[6] + (l * 3) * DM; E.b = p.in[7] + (l * 3) * DM;
        const u16* Bt = even ? (const u16*)(p.ws + WS_EV_OUT + (size_t)j * SZ_SQ) : (const u16*)(p.ws + WS_OD_OUT + (size_t)j * SZ_SQ);
        run_gemm(shm, XB, Bt, NTOK, 1024, 1024, E);
    }
}

#ifndef PROBE_MASK
#define PROBE_MASK 0
#endif
__device__ __forceinline__ bool probe_repeat(int ph) {
    if (ph == 0) return (PROBE_MASK & 4) != 0;
    const int s = (ph - 1) % PH_PER_LAYER;
    if (s < 5 || s >= 26) { const int ss = s >= 26 ? s - 26 : s; if (ss == 4) return (PROBE_MASK & 16) && !(s >= 26 && (ph - 1) / PH_PER_LAYER == 3); if (ss == 1 || ss == 3) return (PROBE_MASK & 64) && (ph > 5); return (PROBE_MASK & 2) && (ss == 0 || ss == 2); }
    if (s == 25) return (PROBE_MASK & 16) != 0;
    const int k = (s - 5) % 5;
    if (k == 0) return (PROBE_MASK & 2) != 0;
    if (k == 1 || k == 3) return (PROBE_MASK & 1) != 0;
    if (k == 2) return (PROBE_MASK & 32) != 0;
    if (k == 4) return (PROBE_MASK & 64) != 0;
    return false;
}
constexpr size_t WS_BAR = WS_STATS + (size_t)NTOK * 8;
constexpr size_t LDS_MAIN = SCAN_LDS > 131072 ? SCAN_LDS : 131072;
__device__ __forceinline__ bool phase_is_noop(int ph) {
    if (ph == 0) return false;
    const int s = (ph - 1) % PH_PER_LAYER;
    return s >= 5 && s < 25 && ((s - 5) % 5) == 4 && ((s - 5) / 5) < 3;
}
template <bool COOP>
__global__ __launch_bounds__(512, 2) void hybrid_mega(Params p, int ph0, int ph1) {
    extern __shared__ __attribute__((aligned(16))) unsigned char shm[];
    volatile LAS unsigned* st = (volatile LAS unsigned*)((LAS unsigned char*)shm + LDS_MAIN);
    if (threadIdx.x == 0) { st[0] = 0u; st[1] = 0u; st[2] = 0u; st[3] = 0u; }
    __syncthreads();
    XcdBarrier xb = xcd_barrier_post((unsigned*)(p.ws + WS_BAR), st);
    for (int ph = ph0; ph < ph1; ++ph) {
        if (phase_is_noop(ph)) continue;
#if PROBE_MASK
        const int nrep = probe_repeat(ph) ? 2 : 1;
#pragma unroll 1
        for (int rep = 0; rep < nrep; ++rep) {
            run_phase(p, ph, shm, rep > 0);
            if (COOP) { if (ph == 0 && rep == 0) cg::this_grid().sync(); else xcd_barrier(xb); }
            if (PROBE_MASK & 8) { if (COOP) xcd_barrier(xb); }
        }
#else
        run_phase(p, ph, shm, false);
        if (COOP && ph + 1 < ph1) { if (ph == 0) cg::this_grid().sync(); else xcd_barrier(xb); }
#endif
    }
}

#ifndef USE_COOP
#define USE_COOP 1
#endif

extern "C" void kernel_launch(void* const* d_in, const int* in_sizes, int n_in, void* d_out, int out_size, void* d_ws, size_t ws_size, hipStream_t stream) {
    (void)in_sizes; (void)n_in; (void)out_size; (void)ws_size;
    Params p{};
    for (int i = 0; i < 19; ++i) p.in[i] = (const float*)d_in[i];
    p.X = (float*)d_out; p.ws = (unsigned char*)d_ws;
    constexpr size_t kLds = LDS_MAIN + 16;
#if USE_COOP
    static int grid_blocks = 0;
    if (!grid_blocks) {
        hipFuncSetAttribute((const void*)hybrid_mega<true>, hipFuncAttributeMaxDynamicSharedMemorySize, (int)kLds);
        int dev = 0, cus = 0, per_cu = 0;
        hipGetDevice(&dev);
        hipDeviceGetAttribute(&cus, hipDeviceAttributeMultiprocessorCount, dev);
        hipOccupancyMaxActiveBlocksPerMultiprocessor(&per_cu, hybrid_mega<true>, 512, kLds);
        if (per_cu < 1) per_cu = 1;
        grid_blocks = cus * 1;
    }
    hipMemsetAsync((unsigned char*)d_ws + WS_BAR, 0, XCD_BAR_WORDS * sizeof(unsigned), stream);
    int ph0 = 0, ph1 = N_PHASES;
    void* args[] = {&p, &ph0, &ph1};
    hipLaunchCooperativeKernel((const void*)hybrid_mega<true>, dim3(grid_blocks), dim3(512), args, kLds, stream);
#else
    static int inited = 0;
    if (!inited) { hipFuncSetAttribute((const void*)hybrid_mega<false>, hipFuncAttributeMaxDynamicSharedMemorySize, (int)kLds); inited = 1; }
    for (int ph = 0; ph < N_PHASES; ++ph) hybrid_mega<false><<<256, 512, kLds, stream>>>(p, ph, ph + 1);
#endif
}
```
